# Optimizing an MI355X kernel written in HIP

```python
import math
import jax, jax.numpy as jnp
from jax import lax
import numpy as np

D_MODEL = 1024
BATCH = 8
SEQ = 4096
DEPTH = 1

CHUNK = 64
SGU_BLOCK = 128
Q_BLOCK = 128
E_A = D_MODEL
A_GROUPS = 8
A_GROUP_DIM = E_A // A_GROUPS
FOX_HEADS = 8
FOX_HEAD_DIM = D_MODEL // FOX_HEADS
E_B = FOX_HEADS * FOX_HEAD_DIM
EPS = 1e-6
NEG_INF = -1e30
SPLITS = (E_A, E_A, E_A, E_B, E_B, E_B, E_B, FOX_HEADS, D_MODEL, D_MODEL)
N_IN = sum(SPLITS)

kernel_name = "hybrid_gmlp_fox_gated_block"


def rmsnorm(x, g):
    xf = x.astype(jnp.float32)
    y = xf * lax.rsqrt(jnp.mean(xf * xf, axis=-1, keepdims=True) + EPS)
    return (y * g.astype(jnp.float32)).astype(x.dtype)


def sgu_branch(u, v, z, ln_g, ln_b, w_s, b_s):
    B, S, _ = v.shape
    nb = S // SGU_BLOCK
    vg = v.reshape(B, nb, SGU_BLOCK, A_GROUPS, A_GROUP_DIM).astype(jnp.float32)
    mu = jnp.mean(vg, axis=-1, keepdims=True)
    var = jnp.mean(jnp.square(vg - mu), axis=-1, keepdims=True)
    vn = (vg - mu) * lax.rsqrt(var + EPS)
    vn = (vn * ln_g.reshape(A_GROUPS, A_GROUP_DIM) + ln_b.reshape(A_GROUPS, A_GROUP_DIM)).astype(v.dtype)
    pos = jnp.arange(SGU_BLOCK)
    mask = (pos[:, None] // CHUNK) >= (pos[None, :] // CHUNK)
    ws = jnp.where(mask[None], w_s, jnp.zeros_like(w_s))
    y = jnp.einsum('gts,bnsgc->bntgc', ws, vn) + b_s.T[None, None, :, :, None]
    y = y.reshape(B, S, E_A)
    return u * y * jax.nn.silu(z)


def fox_branch(q, k, v, z, f_logit, b_f):
    B, S, _ = q.shape
    to_heads = lambda t: t.reshape(B, S, FOX_HEADS, FOX_HEAD_DIM).transpose(0, 2, 1, 3)
    qh, kh, vh = to_heads(q), to_heads(k), to_heads(v)
    log_f = jax.nn.log_sigmoid((f_logit + b_f).astype(jnp.float32))
    c = jnp.cumsum(log_f.transpose(0, 2, 1), axis=-1)
    scale = 1.0 / math.sqrt(FOX_HEAD_DIM)
    outs = []
    for i in range(S // Q_BLOCK):
        s0 = i * Q_BLOCK
        end = s0 + Q_BLOCK
        qb, kb, vb = qh[:, :, s0:end], kh[:, :, :end], vh[:, :, :end]
        logits = jnp.einsum('bhqd,bhkd->bhqk', qb, kb).astype(jnp.float32) * scale
        logits = logits + c[:, :, s0:end, None] - c[:, :, None, :end]
        mask = (s0 + jnp.arange(Q_BLOCK))[:, None] >= jnp.arange(end)[None, :]
        logits = jnp.where(mask[None, None], logits, NEG_INF)
        p = jax.nn.softmax(logits, axis=-1).astype(vb.dtype)
        outs.append(jnp.einsum('bhqk,bhkd->bhqd', p, vb))
    o = jnp.concatenate(outs, axis=2).transpose(0, 2, 1, 3).reshape(B, S, E_B)
    return o * jax.nn.silu(z)


def setup_inputs(seed: int = 0) -> dict:
    key = jax.random.key(seed)
    ks = jax.random.split(key, 16)
    nrm = lambda k, shape, s: jax.random.normal(k, shape, jnp.float32) * s
    return {
        "x": nrm(ks[0], (BATCH, SEQ, D_MODEL), 1.0),
        "norm1_g": 1.0 + nrm(ks[1], (D_MODEL,), 0.02),
        "w_in": nrm(ks[2], (D_MODEL, N_IN), D_MODEL ** -0.5),
        "sgu_ln_g": 1.0 + nrm(ks[3], (E_A,), 0.02),
        "sgu_ln_b": nrm(ks[4], (E_A,), 0.02),
        "w_spatial": nrm(ks[5], (A_GROUPS, SGU_BLOCK, SGU_BLOCK), SGU_BLOCK ** -0.5),
        "b_spatial": 1.0 + nrm(ks[6], (A_GROUPS, SGU_BLOCK), 0.02),
        "b_forget": 3.0 + nrm(ks[7], (FOX_HEADS,), 0.5),
        "b_gate": nrm(ks[8], (2, D_MODEL), 0.02),
        "w_proj_a": nrm(ks[9], (E_A, D_MODEL), E_A ** -0.5),
        "w_proj_b": nrm(ks[10], (E_B, D_MODEL), E_B ** -0.5),
        "w_out": nrm(ks[11], (D_MODEL, D_MODEL), D_MODEL ** -0.5),
        "norm_f_g": 1.0 + nrm(ks[12], (D_MODEL,), 0.02),
    }


def reference(x, norm1_g, w_in, sgu_ln_g, sgu_ln_b, w_spatial, b_spatial, b_forget,
              b_gate, w_proj_a, w_proj_b, w_out, norm_f_g):
    h = x
    for _ in range(DEPTH):
        xn = rmsnorm(h, norm1_g)
        proj = jnp.einsum('bsd,dn->bsn', xn, w_in)
        idx = list(np.cumsum(SPLITS)[:-1])
        u_a, v_a, z_a, q, k, v, z_b, f_logit, g_a, g_b = jnp.split(proj, idx, axis=-1)
        a = sgu_branch(u_a, v_a, z_a, sgu_ln_g, sgu_ln_b, w_spatial, b_spatial)
        o = fox_branch(q, k, v, z_b, f_logit, b_forget)
        merged = (jax.nn.sigmoid(g_a + b_gate[0]) * jnp.einsum('bse,ed->bsd', a, w_proj_a)
                  + jax.nn.sigmoid(g_b + b_gate[1]) * jnp.einsum('bse,ed->bsd', o, w_proj_b))
        h = h + jnp.einsum('bsd,de->bse', merged, w_out)
    return rmsnorm(h, norm_f_g)
```

```cpp
#include <hip/hip_runtime.h>
#include <hip/hip_cooperative_groups.h>
#include <cstdio>
#include <cstdint>
#include <cmath>
namespace cg = cooperative_groups;
namespace pg8 {
#define PG8_LAS __attribute__((address_space(3)))
typedef unsigned short bf16_t;
typedef short bf16x8 __attribute__((ext_vector_type(8)));
typedef float f32x4 __attribute__((ext_vector_type(4)));
typedef unsigned u32x4 __attribute__((ext_vector_type(4)));
constexpr int BM = 256, BK = 64, HALF = 128, HTB = HALF * BK * 2  , STAGE_BYTES = 8 * HTB, NXCD = 8, WGM = 8;

__host__ __device__ __forceinline__ int lds_byte(int r, int c) { const int st = (r >> 4) * 2 + (c >> 5), rr = r & 15, cc = c & 31, ob = rr * 64 + cc * 2; return st * 1024 + (ob ^ (((ob >> 9) & 1) << 5)); }
__host__ __device__ __forceinline__ void stage_rc(int b, int& R, int& C) { const int st = b / 1024, sb = b % 1024, swz = sb ^ (((sb >> 9) & 1) << 5); R = (st >> 1) * 16 + swz / 64; C = (st & 1) * 32 + (swz % 64) / 2; }
__host__ __device__ __forceinline__ int perm32(int rho) { const int n = rho >> 4, i = rho & 15; return 8 * (i >> 2) + 4 * n + (i & 3); }

struct Unit { int pm, pn; };
struct Gemm { const bf16_t* A; const bf16_t* Bt; int M, N, K; };

struct StaticOrder {
    int nM, nN, nwg, G, c;
    __host__ __device__ void init(int M, int N, int G_, int c_) { nM = M / BM; nN = N / BM; nwg = nM * nN; G = G_; c = c_; }
    __host__ __device__ bool next(int i, Unit& u) const {
        const long L = (long)i * G + c; if (L >= nwg) return false;
        int wgid = (int)L; { const int q = nwg / NXCD, r = nwg % NXCD, xcd = wgid % NXCD, off = wgid / NXCD; wgid = (xcd < r ? xcd * (q + 1) : r * (q + 1) + (xcd - r) * q) + off; }
        const int nig = WGM * nN, gid = wgid / nig, fm = gid * WGM, gsz = (nM - fm) < WGM ? (nM - fm) : WGM;
        u.pm = fm + ((wgid % nig) % gsz); u.pn = (wgid % nig) / gsz; return true;
    }
    __device__ __forceinline__ void a_ready(const Unit&) const {}
    __device__ __forceinline__ void done(const Unit&) const {}
};

__device__ __forceinline__ unsigned cvt_pk_bf16(float lo, float hi) { unsigned r; asm volatile("v_cvt_pk_bf16_f32 %0, %1, %2" : "=v"(r) : "v"(lo), "v"(hi)); return r; }
typedef float f32x2 __attribute__((ext_vector_type(2)));

__device__ __forceinline__ float silu_f(float v) { return v * __builtin_amdgcn_rcpf(1.0f + __builtin_amdgcn_exp2f(-1.4426950408889634f * v)); }
__device__ __forceinline__ float sigm_f(float v) { return __builtin_amdgcn_rcpf(1.0f + __builtin_amdgcn_exp2f(-1.4426950408889634f * v)); }
typedef float f32x2c_t __attribute__((ext_vector_type(2))); typedef __bf16 bf16x2c_t __attribute__((ext_vector_type(2)));
__device__ __forceinline__ unsigned cvt_pk_bf16_c(float lo, float hi) { f32x2c_t v = {lo, hi}; bf16x2c_t b = __builtin_convertvector(v, bf16x2c_t); return __builtin_bit_cast(unsigned, b); }
__device__ __forceinline__ float bf_lo(unsigned w) { return __uint_as_float(w << 16); }
__device__ __forceinline__ float bf_hi(unsigned w) { return __uint_as_float(w & 0xffff0000u); }

struct EpiP1 {
    static constexpr bool PERM = true, AFTER_DRAIN = false, HAS_MID = false; static constexpr int MID_T = -1;
    bf16_t *AO, *VA, *ZA, *KB, *VB, *ZB;
    __device__ __forceinline__ void mid(f32x4 (&)[2][2][4][2], const Unit&, int, int, int, int) const {}
    __device__ __forceinline__ void operator()(const f32x4 (&acc)[2][2][4][2], const Unit& u, int wr, int wc, int fr, int fq) const {
        const int g = u.pn >> 2, cin = (u.pn & 3) * BM;
        bf16_t* base = g == 0 ? AO : g == 1 ? VA : g == 2 ? ZA : g == 3 ? AO + 1024 : g == 4 ? KB : g == 5 ? VB : ZB;
        const int ldc = (g == 0 || g == 3) ? 2048 : 1024;
        const bool act = (g == 2 || g == 6);
        const int row0 = u.pm * BM + wr * 64 + fr, col0 = cin + wc * 32 + 8 * fq;
#pragma unroll
        for (int ai = 0; ai < 2; ++ai)
#pragma unroll
            for (int m = 0; m < 4; ++m) { bf16_t* rowp = base + (size_t)(row0 + ai * HALF + m * 16) * ldc + col0;
#pragma unroll
                for (int bj = 0; bj < 2; ++bj) { f32x4 v0 = acc[ai][bj][m][0], v1 = acc[ai][bj][m][1];
                    if (act) {
#pragma unroll
                        for (int e = 0; e < 4; ++e) { v0[e] = silu_f(v0[e]); v1[e] = silu_f(v1[e]); } }
                    u32x4 w; w.x = cvt_pk_bf16(v0[0], v0[1]); w.y = cvt_pk_bf16(v0[2], v0[3]); w.z = cvt_pk_bf16(v1[0], v1[1]); w.w = cvt_pk_bf16(v1[2], v1[3]);
                    *(u32x4*)(rowp + bj * HALF) = w; } }
    }
};
struct EpiGate {
    static constexpr bool PERM = true, AFTER_DRAIN = false, HAS_MID = false; static constexpr int MID_T = -1;
    bf16_t *GA, *GB; const float* bias;
    __device__ __forceinline__ void mid(f32x4 (&)[2][2][4][2], const Unit&, int, int, int, int) const {}
    __device__ __forceinline__ void operator()(const f32x4 (&acc)[2][2][4][2], const Unit& u, int wr, int wc, int fr, int fq) const {
        const int g = u.pn >> 2, cin = (u.pn & 3) * BM;
        bf16_t* base = g == 0 ? GA : GB;
        const int row0 = u.pm * BM + wr * 64 + fr, col0 = cin + wc * 32 + 8 * fq, bcol0 = u.pn * BM + wc * 32 + 8 * fq;
        f32x4 bv[2][2];
#pragma unroll
        for (int bj = 0; bj < 2; ++bj)
#pragma unroll
            for (int n = 0; n < 2; ++n) bv[bj][n] = *(const f32x4*)(bias + bcol0 + bj * HALF + 4 * n);
#pragma unroll
        for (int ai = 0; ai < 2; ++ai)
#pragma unroll
            for (int m = 0; m < 4; ++m) { bf16_t* rowp = base + (size_t)(row0 + ai * HALF + m * 16) * 1024 + col0;
#pragma unroll
                for (int bj = 0; bj < 2; ++bj) { f32x4 v0 = acc[ai][bj][m][0] + bv[bj][0], v1 = acc[ai][bj][m][1] + bv[bj][1];
#pragma unroll
                    for (int e = 0; e < 4; ++e) { v0[e] = sigm_f(v0[e]); v1[e] = sigm_f(v1[e]); }
                    u32x4 w; w.x = cvt_pk_bf16_c(v0[0], v0[1]); w.y = cvt_pk_bf16_c(v0[2], v0[3]); w.z = cvt_pk_bf16_c(v1[0], v1[1]); w.w = cvt_pk_bf16_c(v1[2], v1[3]);
                    *(u32x4*)(rowp + bj * HALF) = w; } }
    }
};
struct EpiMerged {
    static constexpr bool PERM = true, AFTER_DRAIN = false, HAS_MID = true; static constexpr int MID_T = 16;
    const bf16_t *GA, *GB; bf16_t* MG;
    __device__ __forceinline__ void mid(f32x4 (&acc)[2][2][4][2], const Unit& u, int wr, int wc, int fr, int fq) const {
        asm volatile("" : "+v"(fr), "+v"(fq));
        const int row0 = u.pm * BM + wr * 64 + fr, col0 = u.pn * BM + wc * 32 + 8 * fq;
#pragma unroll
        for (int ai = 0; ai < 2; ++ai)
#pragma unroll
            for (int m = 0; m < 4; ++m) { const size_t off = (size_t)(row0 + ai * HALF + m * 16) * 1024 + col0;
#pragma unroll
                for (int bj = 0; bj < 2; ++bj) { const u32x4 a = *(const u32x4*)(GA + off + bj * HALF), b = *(const u32x4*)(GB + off + bj * HALF);
                    f32x4 r0, r1;
                    r0[0] = bf_lo(a.x) * __builtin_amdgcn_rcpf(bf_lo(b.x)); r0[1] = bf_hi(a.x) * __builtin_amdgcn_rcpf(bf_hi(b.x));
                    r0[2] = bf_lo(a.y) * __builtin_amdgcn_rcpf(bf_lo(b.y)); r0[3] = bf_hi(a.y) * __builtin_amdgcn_rcpf(bf_hi(b.y));
                    r1[0] = bf_lo(a.z) * __builtin_amdgcn_rcpf(bf_lo(b.z)); r1[1] = bf_hi(a.z) * __builtin_amdgcn_rcpf(bf_hi(b.z));
                    r1[2] = bf_lo(a.w) * __builtin_amdgcn_rcpf(bf_lo(b.w)); r1[3] = bf_hi(a.w) * __builtin_amdgcn_rcpf(bf_hi(b.w));
                    acc[ai][bj][m][0] *= r0; acc[ai][bj][m][1] *= r1; }
                if (m & 1) asm volatile("" ::: "memory"); }
    }
    __device__ __forceinline__ void operator()(const f32x4 (&acc)[2][2][4][2], const Unit& u, int wr, int wc, int fr, int fq) const {
        const int row0 = u.pm * BM + wr * 64 + fr, col0 = u.pn * BM + wc * 32 + 8 * fq;
#pragma unroll
        for (int ai = 0; ai < 2; ++ai)
#pragma unroll
            for (int m = 0; m < 4; ++m) { const size_t off = (size_t)(row0 + ai * HALF + m * 16) * 1024 + col0;
#pragma unroll
                for (int bj = 0; bj < 2; ++bj) { const u32x4 b = *(const u32x4*)(GB + off + bj * HALF);
                    const f32x4 v0 = acc[ai][bj][m][0], v1 = acc[ai][bj][m][1];
                    u32x4 w; w.x = cvt_pk_bf16(v0[0] * bf_lo(b.x), v0[1] * bf_hi(b.x)); w.y = cvt_pk_bf16(v0[2] * bf_lo(b.y), v0[3] * bf_hi(b.y));
                    w.z = cvt_pk_bf16(v1[0] * bf_lo(b.z), v1[1] * bf_hi(b.z)); w.w = cvt_pk_bf16(v1[2] * bf_lo(b.w), v1[3] * bf_hi(b.w));
                    *(u32x4*)(MG + off + bj * HALF) = w; } }
    }
};

struct EpiOutNorm {
    static constexpr bool PERM = false, AFTER_DRAIN = false, HAS_MID = false; static constexpr int MID_T = -1;
    const float* x; float* out; float* ssq; unsigned* cnt; const float* gw; float eps;
    __device__ __forceinline__ void mid(f32x4 (&)[2][2][4][2], const Unit&, int, int, int, int) const {}
    __device__ __forceinline__ void operator()(f32x4 (&acc)[2][2][4][2], const Unit& u, int wr, int wc, int fr, int fq) const {
        const int row0 = u.pm * BM + wr * 64 + fr, col0 = u.pn * BM + wc * 32 + 4 * fq;
#pragma unroll
        for (int ai = 0; ai < 2; ++ai)
#pragma unroll
            for (int m = 0; m < 4; ++m) { const int row = row0 + ai * HALF + m * 16; const size_t off = (size_t)row * 1024 + col0; float s = 0.f;
#pragma unroll
                for (int bj = 0; bj < 2; ++bj)
#pragma unroll
                    for (int n = 0; n < 2; ++n) { const f32x4 xv = *(const f32x4*)(x + off + bj * HALF + n * 16); const f32x4 h = xv + acc[ai][bj][m][n]; acc[ai][bj][m][n] = h;
                        s += (h[0] * h[0] + h[1] * h[1]) + (h[2] * h[2] + h[3] * h[3]); }
                s += __shfl_xor(s, 16); s += __shfl_xor(s, 32);
                if (fq == 0) __hip_atomic_fetch_add(ssq + row, s, __ATOMIC_RELAXED, __HIP_MEMORY_SCOPE_AGENT);
                asm volatile("" ::: "memory"); }
        asm volatile("s_waitcnt vmcnt(0)" ::: "memory");
        unsigned* c = cnt + 64 * u.pm;
        if ((threadIdx.x & 63) == 0) __hip_atomic_fetch_add(c, 1u, __ATOMIC_RELAXED, __HIP_MEMORY_SCOPE_AGENT);
        { unsigned sp = 0; while ((unsigned)__builtin_amdgcn_readfirstlane(__hip_atomic_load(c, __ATOMIC_RELAXED, __HIP_MEMORY_SCOPE_AGENT)) < 32u) { __builtin_amdgcn_s_sleep(2); if (++sp > (1u << 22)) break; } }
        asm volatile("" ::: "memory");
        f32x4 gv[2][2];
#pragma unroll
        for (int bj = 0; bj < 2; ++bj)
#pragma unroll
            for (int n = 0; n < 2; ++n) gv[bj][n] = *(const f32x4*)(gw + col0 + bj * HALF + n * 16);
#pragma unroll
        for (int ai = 0; ai < 2; ++ai)
#pragma unroll
            for (int m = 0; m < 4; ++m) { const int row = row0 + ai * HALF + m * 16; const size_t off = (size_t)row * 1024 + col0;
                const float ss = __hip_atomic_load(ssq + row, __ATOMIC_RELAXED, __HIP_MEMORY_SCOPE_AGENT);
                const float rstd = 1.0f / sqrtf(ss * (1.0f / 1024.0f) + eps);
#pragma unroll
                for (int bj = 0; bj < 2; ++bj)
#pragma unroll
                    for (int n = 0; n < 2; ++n) *(f32x4*)(out + off + bj * HALF + n * 16) = acc[ai][bj][m][n] * rstd * gv[bj][n]; }
    }
};
struct EpiOut {
    static constexpr bool PERM = false, AFTER_DRAIN = false, HAS_MID = false; static constexpr int MID_T = -1;
    const float* x; float* out; float* ssq;
    __device__ __forceinline__ void mid(f32x4 (&)[2][2][4][2], const Unit&, int, int, int, int) const {}
    __device__ __forceinline__ void operator()(const f32x4 (&acc)[2][2][4][2], const Unit& u, int wr, int wc, int fr, int fq) const {
        const int row0 = u.pm * BM + wr * 64 + fr, col0 = u.pn * BM + wc * 32 + 4 * fq;
#pragma unroll
        for (int ai = 0; ai < 2; ++ai)
#pragma unroll
            for (int m = 0; m < 4; ++m) { const int row = row0 + ai * HALF + m * 16; const size_t off = (size_t)row * 1024 + col0; float s = 0.f;
#pragma unroll
                for (int bj = 0; bj < 2; ++bj)
#pragma unroll
                    for (int n = 0; n < 2; ++n) { const f32x4 xv = *(const f32x4*)(x + off + bj * HALF + n * 16); const f32x4 h = xv + acc[ai][bj][m][n];
                        s += (h[0] * h[0] + h[1] * h[1]) + (h[2] * h[2] + h[3] * h[3]); *(f32x4*)(out + off + bj * HALF + n * 16) = h; }
                s += __shfl_xor(s, 16); s += __shfl_xor(s, 32);
                if (fq == 0) atomicAdd(ssq + row, s); }
    }
};
template <class Epi, class Sched, bool ALIGN_EPI = false, bool SP2 = false>
__device__ __forceinline__ void gemm_phase(PG8_LAS unsigned char* lds, const Gemm g, const Sched& S, const Epi& E) {
    const int tid = threadIdx.x, wid = __builtin_amdgcn_readfirstlane(tid >> 6), lane = tid & 63, wr = wid >> 2, wc = wid & 3, fr = lane & 15, fq = lane >> 4;
    const int K = g.K, nt = K / BK;
    unsigned voffA[2], voffB[2];
#pragma unroll
    for (int i = 0; i < 2; ++i) { int R, C; stage_rc(tid * 16 + i * 8192, R, C); const int Rb = Epi::PERM ? ((R & ~31) + perm32(R & 31)) : R;
        voffA[i] = (unsigned)(R * K + C) * 2u; voffB[i] = (unsigned)(Rb * K + C) * 2u; }
    const size_t kstep = (size_t)(BK * 2);
    const size_t hstep = (size_t)HALF * K * 2;
    const size_t tstep = 2 * hstep;
    const unsigned ldsw = (unsigned)wid * 1024u;
    const int aoff = lds_byte(wr * 64 + fr, fq * 8), boff = lds_byte(wc * 32 + fr, fq * 8);
#define PG8_SA(b, h) (((b) * 2 + (h)) * HTB)
#define PG8_SB(b, h) ((4 + (b) * 2 + (h)) * HTB)
#define PG8_STAGE(bufoff, gbase, voff) do { _Pragma("unroll") for (int _i = 0; _i < 2; ++_i) \
        __builtin_amdgcn_global_load_lds((const unsigned*)((const char*)(gbase) + (voff)[_i]), (PG8_LAS unsigned*)(lds + (bufoff) + ldsw + _i * 8192), 16, 0, 0); } while (0)
#define PG8_LDA(dst, b, h) do { _Pragma("unroll") for (int m = 0; m < 4; ++m) _Pragma("unroll") for (int k = 0; k < 2; ++k) dst[m][k] = *(const PG8_LAS bf16x8*)(lds + PG8_SA(b, h) + aoff + m * 2048 + k * 1024); } while (0)
#define PG8_LDB(dst, b, h) do { _Pragma("unroll") for (int n = 0; n < 2; ++n) _Pragma("unroll") for (int k = 0; k < 2; ++k) dst[n][k] = *(const PG8_LAS bf16x8*)(lds + PG8_SB(b, h) + boff + n * 2048 + k * 1024); } while (0)
#define PG8_MMA(ai, bj, At, Bt) do { __builtin_amdgcn_s_setprio(1); _Pragma("unroll") for (int m = 0; m < 4; ++m) _Pragma("unroll") for (int n = 0; n < 2; ++n) _Pragma("unroll") for (int k = 0; k < 2; ++k) \
        acc[ai][bj][m][n] = __builtin_amdgcn_mfma_f32_16x16x32_bf16(Bt[n][k], At[m][k], acc[ai][bj][m][n], 0, 0, 0); __builtin_amdgcn_s_setprio(0); } while (0)
#define PG8_WAIT_V(n) asm volatile("s_waitcnt vmcnt(" #n ")" ::: "memory")
#define PG8_WAIT_L(n) asm volatile("s_waitcnt lgkmcnt(" #n ")" ::: "memory")
#define PG8_BAR __builtin_amdgcn_s_barrier()
#define PG8_SCHED __builtin_amdgcn_sched_barrier(0)
    Unit cur, nxt; int ui = 0;
    if (!S.next(0, cur)) return;
    f32x4 acc[2][2][4][2];
#pragma unroll
    for (int a = 0; a < 2; ++a)
#pragma unroll
        for (int b = 0; b < 2; ++b)
#pragma unroll
            for (int m = 0; m < 4; ++m)
#pragma unroll
                for (int n = 0; n < 2; ++n) acc[a][b][m][n] = (f32x4){0.f, 0.f, 0.f, 0.f};
    bf16x8 At[4][2], B0[2][2], B1[2][2];
    const char* cA = (const char*)g.A + (size_t)cur.pm * tstep; const char* cB = (const char*)g.Bt + (size_t)cur.pn * tstep;
    S.a_ready(cur);
    if constexpr (SP2) {
        PG8_STAGE(PG8_SB(0, 0), cB, voffB); PG8_STAGE(PG8_SB(0, 1), cB + hstep, voffB); PG8_STAGE(PG8_SA(0, 0), cA, voffA); PG8_STAGE(PG8_SA(0, 1), cA + hstep, voffA);
        if (wr == 1) PG8_BAR;
        PG8_WAIT_V(2); PG8_BAR;
        PG8_STAGE(PG8_SB(1, 0), cB + kstep, voffB); PG8_STAGE(PG8_SA(1, 0), cA + kstep, voffA); PG8_STAGE(PG8_SB(1, 1), cB + hstep + kstep, voffB);
        PG8_WAIT_V(6); PG8_BAR;
    } else {
        PG8_STAGE(PG8_SB(0, 0), cB, voffB); PG8_STAGE(PG8_SA(0, 0), cA, voffA); PG8_STAGE(PG8_SB(0, 1), cB + hstep, voffB); PG8_STAGE(PG8_SA(0, 1), cA + hstep, voffA);
        if (wr == 1) PG8_BAR;
        PG8_WAIT_V(4); PG8_BAR;
        PG8_STAGE(PG8_SB(1, 0), cB + kstep, voffB); PG8_STAGE(PG8_SA(1, 0), cA + kstep, voffA); PG8_STAGE(PG8_SB(1, 1), cB + hstep + kstep, voffB);
        PG8_WAIT_V(6); PG8_BAR;
    }
    for (;;) {
        const bool has_next = S.next(ui + 1, nxt);
        const char* nA = has_next ? (const char*)g.A + (size_t)nxt.pm * tstep : cA; const char* nB = has_next ? (const char*)g.Bt + (size_t)nxt.pn * tstep : cB;
        for (int t = 0; t < nt; t += 2) {
            if constexpr (Epi::HAS_MID) { if (t == Epi::MID_T) E.mid(acc, cur, wr, wc, fr, fq); }
            const bool last = (t == nt - 2);
            const char* a1 = cA + (size_t)(t + 1) * kstep;
            const char* a2 = last ? nA : cA + (size_t)(t + 2) * kstep; const char* b2 = last ? nB : cB + (size_t)(t + 2) * kstep;
            const char* a3 = a2 + kstep; const char* b3 = b2 + kstep;
            if (last && has_next) S.a_ready(nxt);
            if constexpr (SP2) {
            PG8_LDB(B0, 0, 0); PG8_LDB(B1, 0, 1); PG8_SCHED; PG8_LDA(At, 0, 0); PG8_STAGE(PG8_SA(1, 1), a1 + hstep, voffA);
            PG8_WAIT_V(8); PG8_WAIT_L(0); PG8_BAR; PG8_MMA(0, 0, At, B0); PG8_MMA(0, 1, At, B1); PG8_BAR; PG8_SCHED;
            PG8_LDA(At, 0, 1); PG8_STAGE(PG8_SB(0, 0), b2, voffB); PG8_STAGE(PG8_SB(0, 1), b2 + hstep, voffB); PG8_STAGE(PG8_SA(0, 0), a2, voffA);
            PG8_WAIT_V(8); PG8_WAIT_L(0); PG8_BAR; PG8_MMA(1, 0, At, B0); PG8_MMA(1, 1, At, B1); PG8_BAR; PG8_SCHED;
            PG8_LDB(B0, 1, 0); PG8_LDB(B1, 1, 1); PG8_SCHED; PG8_LDA(At, 1, 0); PG8_STAGE(PG8_SA(0, 1), a2 + hstep, voffA);
            PG8_WAIT_V(8); PG8_WAIT_L(0); PG8_BAR; PG8_MMA(0, 0, At, B0); PG8_MMA(0, 1, At, B1); PG8_BAR; PG8_SCHED;
            PG8_LDA(At, 1, 1); PG8_STAGE(PG8_SB(1, 0), b3, voffB); PG8_STAGE(PG8_SB(1, 1), b3 + hstep, voffB); PG8_STAGE(PG8_SA(1, 0), a3, voffA);
            PG8_WAIT_V(8); PG8_WAIT_L(0); PG8_BAR; PG8_MMA(1, 0, At, B0); PG8_MMA(1, 1, At, B1); PG8_BAR; PG8_SCHED;
            } else {
            PG8_LDB(B0, 0, 0); PG8_SCHED; PG8_LDA(At, 0, 0); PG8_STAGE(PG8_SA(1, 1), a1 + hstep, voffA);
            PG8_WAIT_L(8); PG8_BAR; PG8_WAIT_L(0); PG8_MMA(0, 0, At, B0); PG8_BAR; PG8_SCHED;
            PG8_LDB(B1, 0, 1); PG8_STAGE(PG8_SB(0, 0), b2, voffB);
            PG8_BAR; PG8_WAIT_L(0); PG8_MMA(0, 1, At, B1); PG8_BAR;
            PG8_LDA(At, 0, 1); PG8_STAGE(PG8_SA(0, 0), a2, voffA);
            PG8_BAR; PG8_WAIT_L(0); PG8_MMA(1, 0, At, B0); PG8_BAR; PG8_SCHED;
            PG8_STAGE(PG8_SB(0, 1), b2 + hstep, voffB);
            PG8_WAIT_V(6); PG8_BAR; PG8_MMA(1, 1, At, B1); PG8_BAR;
            PG8_LDB(B0, 1, 0); PG8_SCHED; PG8_LDA(At, 1, 0); PG8_STAGE(PG8_SA(0, 1), a2 + hstep, voffA);
            PG8_WAIT_L(8); PG8_BAR; PG8_WAIT_L(0); PG8_MMA(0, 0, At, B0); PG8_BAR; PG8_SCHED;
            PG8_LDB(B1, 1, 1); PG8_STAGE(PG8_SB(1, 0), b3, voffB);
            PG8_BAR; PG8_WAIT_L(0); PG8_MMA(0, 1, At, B1); PG8_BAR;
            PG8_LDA(At, 1, 1); PG8_STAGE(PG8_SA(1, 0), a3, voffA);
            PG8_BAR; PG8_WAIT_L(0); PG8_MMA(1, 0, At, B0); PG8_BAR; PG8_SCHED;
            PG8_STAGE(PG8_SB(1, 1), b3 + hstep, voffB);
            PG8_WAIT_V(6); PG8_BAR; PG8_MMA(1, 1, At, B1); PG8_BAR;
            }
        }
        if constexpr (ALIGN_EPI) { if (wr == 0) PG8_BAR; }
        if constexpr (!Epi::AFTER_DRAIN) { E(acc, cur, wr, wc, fr, fq); S.done(cur); }
        if (!has_next) break;
#pragma unroll
        for (int a = 0; a < 2; ++a)
#pragma unroll
            for (int b = 0; b < 2; ++b)
#pragma unroll
                for (int m = 0; m < 4; ++m)
#pragma unroll
                    for (int n = 0; n < 2; ++n) acc[a][b][m][n] = (f32x4){0.f, 0.f, 0.f, 0.f};
        cur = nxt; cA = nA; cB = nB; ++ui;
        if constexpr (ALIGN_EPI) { if (wr == 1) PG8_BAR; }
    }
    PG8_WAIT_V(0);
    if constexpr (!ALIGN_EPI) { if (wr == 0) PG8_BAR; }
    PG8_BAR;
    if constexpr (Epi::AFTER_DRAIN) { E.fused(acc, cur, wr, wc, fr, fq, lds, wid, lane); S.done(cur); }
#undef PG8_SA
#undef PG8_SB
#undef PG8_STAGE
#undef PG8_LDA
#undef PG8_LDB
#undef PG8_MMA
#undef PG8_WAIT_V
#undef PG8_WAIT_L
#undef PG8_BAR
#undef PG8_SCHED
}
}

namespace fa {
typedef unsigned short bf16;
typedef short bf16x8 __attribute__((ext_vector_type(8)));
typedef short s16x4 __attribute__((ext_vector_type(4)));
typedef float f32x16 __attribute__((ext_vector_type(16)));
typedef float f32x4 __attribute__((ext_vector_type(4)));
typedef unsigned u32x4 __attribute__((ext_vector_type(4)));
constexpr int D = 128, QP = 2048, KP = 1024, ZP = 1024, SEQ = 4096;
constexpr float SCALE = 0.08838834764831845f, INV_SCALE = 11.313708498984761f;
constexpr float THR = 8.f;
constexpr int NW = 8, QBLK = 32, KVBLK = 64, QB = NW * QBLK;
constexpr int SHM_V = KVBLK * D * 2, SHM_K = KVBLK * D * 2;
constexpr int LDS_WS_OFF = 2 * SHM_V + 2 * SHM_K;
constexpr int LDS_CB_OFF = LDS_WS_OFF + NW * 64 * 4;
constexpr int CB_BYTES = SEQ * 8;
constexpr int LDS_STG_OFF = LDS_CB_OFF + CB_BYTES;
constexpr int LDS_BYTES = LDS_STG_OFF + NW * 4352;

#define KSWZ(row, colB) ((row) * 256 + ((colB) ^ (((row) & 7) << 4)))
#define SBAR() __builtin_amdgcn_sched_barrier(0)
__device__ __forceinline__ int v_st(int k, int c) { const int kk = (k & ~0xC) | ((k & 4) << 1) | ((k & 8) >> 1); return ((kk >> 3) * 4 + (c >> 5)) * 512 + ((kk & 7) * 32 + (c & 31)) * 2; }
__device__ __forceinline__ int v_rd_base(int lane) { return ((lane & 3) << 3) | (((lane >> 2) & 3) << 6) | (((lane >> 4) & 1) << 5) | (((lane >> 5) & 1) << 8); }
constexpr int v_rd_off(int d0, int ks, int half) { return d0 * 512 + ks * 4096 + half * 2048; }
__device__ __forceinline__ int crow(int r, int hi) { return (r & 3) + 8 * (r >> 2) + 4 * hi; }
__device__ __forceinline__ unsigned cvtpk(float lo, float hi) { unsigned r; asm volatile("v_cvt_pk_bf16_f32 %0, %1, %2" : "=v"(r) : "v"(lo), "v"(hi)); return r; }
__device__ __forceinline__ bf16x8 load8(const bf16* p) { return *reinterpret_cast<const bf16x8*>(p); }
__device__ __forceinline__ void mask_tile(f32x16& p0, f32x16& p1, int dq, unsigned W) {
    const float NEG = -__builtin_inff();
#pragma unroll
    for (int r = 0; r < 16; ++r) {
        const int c = (r & 3) + 8 * (r >> 2);
        if ((unsigned)(dq - c) >= W) p0[r] = NEG;
        if ((unsigned)(dq - c - 32) >= W) p1[r] = NEG;
    }
}
__device__ __forceinline__ void partialSM(f32x16& p0, f32x16& p1, float& m_reg, float& mn, float& alpha) {
    float pmax = p0[0]; for (int r = 1; r < 16; ++r) pmax = fmaxf(pmax, p0[r]); for (int r = 0; r < 16; ++r) pmax = fmaxf(pmax, p1[r]);
    { auto rr = __builtin_amdgcn_permlane32_swap(__float_as_uint(pmax), __float_as_uint(pmax), false, false);
      pmax = fmaxf(__uint_as_float(rr[0]), __uint_as_float(rr[1])); }
    constexpr float C2 = 1.4426950408889634f * SCALE;
    if (__builtin_expect(__all((pmax - m_reg) * SCALE <= THR), 1)) { mn = m_reg; alpha = 1.f; }
    else { mn = fmaxf(m_reg, pmax); alpha = __builtin_amdgcn_exp2f((m_reg - mn) * C2); m_reg = mn; }
    const float mnL = -mn * C2;
    for (int r = 0; r < 16; ++r) p0[r] = fmaf(p0[r], C2, mnL); for (int r = 0; r < 16; ++r) p1[r] = fmaf(p1[r], C2, mnL);
    for (int r = 0; r < 16; ++r) p0[r] = __builtin_amdgcn_exp2f(p0[r]);
}
__device__ __forceinline__ void finishSM(f32x16& p0, f32x16& p1, float alpha, float& l_reg, bf16x8& pa0, bf16x8& pa1, bf16x8& pa2, bf16x8& pa3) {
    for (int r = 0; r < 16; ++r) p1[r] = __builtin_amdgcn_exp2f(p1[r]);
    float ps = 0; for (int r = 0; r < 16; ++r) ps += p0[r]; for (int r = 0; r < 16; ++r) ps += p1[r];
    { auto rr = __builtin_amdgcn_permlane32_swap(__float_as_uint(ps), __float_as_uint(ps), false, false);
      ps = __uint_as_float(rr[0]) + __uint_as_float(rr[1]); }
    l_reg = l_reg * alpha + ps;
#define PK4(P, B_, OUT) do { unsigned a0 = cvtpk(P[B_+0], P[B_+1]), a1 = cvtpk(P[B_+2], P[B_+3]);                          \
        unsigned b0 = cvtpk(P[B_+4], P[B_+5]), b1 = cvtpk(P[B_+6], P[B_+7]);                                             \
        auto r0 = __builtin_amdgcn_permlane32_swap(a0, b0, false, false); auto r1 = __builtin_amdgcn_permlane32_swap(a1, b1, false, false); \
        u32x4 w = {r0[0], r1[0], r0[1], r1[1]}; OUT = *reinterpret_cast<bf16x8*>(&w); } while (0)
    PK4(p0, 0, pa0); PK4(p0, 8, pa1); PK4(p1, 0, pa2); PK4(p1, 8, pa3);
#undef PK4
}
typedef unsigned u32x2 __attribute__((ext_vector_type(2)));
template <int KB>
__device__ __forceinline__ void qkt(f32x16& p0, f32x16& p1, const char* K_lds, const char* cbt, int r32, int hi, const bf16x8* qr) {
    { const u32x2 e0 = *(const u32x2*)(cbt), e1 = *(const u32x2*)(cbt + 32 * 8);
      const unsigned c0 = hi ? 0u : 0x3F803F80u, c1 = hi ? 0u : 0x00003F80u;
      const u32x4 k0 = {e0.x, e0.y, e0.x, e0.y}, k1 = {e1.x, e1.y, e1.x, e1.y}, q1 = {c0, c1, 0u, 0u};
      p0 = __builtin_amdgcn_mfma_f32_32x32x16_bf16(__builtin_bit_cast(bf16x8, k0), __builtin_bit_cast(bf16x8, q1), f32x16{}, 0, 0, 0);
      p1 = __builtin_amdgcn_mfma_f32_32x32x16_bf16(__builtin_bit_cast(bf16x8, k1), __builtin_bit_cast(bf16x8, q1), f32x16{}, 0, 0, 0); }
    const char* kb[4];
#pragma unroll
    for (int dd = 0; dd < 4; ++dd) kb[dd] = K_lds + KB * SHM_K + KSWZ(r32, (dd * 16 + hi * 8) * 2);
#pragma unroll
    for (int d0 = 0; d0 < 8; ++d0) { const char* a = kb[d0 & 3] + (d0 >> 2) * 128;
        bf16x8 b0 = *reinterpret_cast<const bf16x8*>(a);
        bf16x8 b1 = *reinterpret_cast<const bf16x8*>(a + 32 * 256);
        p0 = __builtin_amdgcn_mfma_f32_32x32x16_bf16(b0, qr[d0], p0, 0, 0, 0);
        p1 = __builtin_amdgcn_mfma_f32_32x32x16_bf16(b1, qr[d0], p1, 0, 0, 0); }
}
template <int VB>
__device__ __forceinline__ void pv_tile(f32x16* o, int vb0, bf16x8 pa0, bf16x8 pa1, bf16x8 pa2, bf16x8 pa3) {
#define TRRD(dst, off) asm volatile("ds_read_b64_tr_b16 %0, %1 offset:%2" : "=&v"(dst) : "v"(vb0), "i"(off) : "memory")
#define VF(l, h) (bf16x8){l[0], l[1], l[2], l[3], h[0], h[1], h[2], h[3]}
#define PV_R(d0, ks, PA, PB) do { s16x4 l0, h0, l1, h1, m0, n0, m1, n1;                                                                \
        constexpr int b_ = VB * SHM_V + v_rd_off(d0, ks, 0), c_ = VB * SHM_V + v_rd_off(d0 + 1, ks, 0);                               \
        TRRD(l0, b_); TRRD(h0, b_ + 2048); TRRD(m0, c_); TRRD(n0, c_ + 2048); TRRD(l1, b_ + 4096); TRRD(h1, b_ + 6144); TRRD(m1, c_ + 4096); TRRD(n1, c_ + 6144); \
        asm volatile("s_waitcnt lgkmcnt(0)" ::: "memory"); SBAR();                                                                   \
        o[d0]     = __builtin_amdgcn_mfma_f32_32x32x16_bf16(PA, VF(l0, h0), o[d0], 0, 0, 0);                                          \
        o[d0 + 1] = __builtin_amdgcn_mfma_f32_32x32x16_bf16(PA, VF(m0, n0), o[d0 + 1], 0, 0, 0);                                      \
        o[d0]     = __builtin_amdgcn_mfma_f32_32x32x16_bf16(PB, VF(l1, h1), o[d0], 0, 0, 0);                                          \
        o[d0 + 1] = __builtin_amdgcn_mfma_f32_32x32x16_bf16(PB, VF(m1, n1), o[d0 + 1], 0, 0, 0); } while (0)
    PV_R(0, 0, pa0, pa1); PV_R(0, 2, pa2, pa3); PV_R(2, 0, pa0, pa1); PV_R(2, 2, pa2, pa3);
#undef PV_R
#undef VF
#undef TRRD
}

struct BlockRef { const bf16* Q; const bf16* K; const bf16* V; bf16* O; const bf16* Z; const float* C; int P0; };
struct Seam { bf16x8 qr[8]; bf16x8 st_v0, st_v1, st_k0, st_k1; };
__device__ __forceinline__ void fill_cb(const float* C, int P0, char* cb) {
    const int n = P0 + QB; const float ref = C[P0];
    for (int i = threadIdx.x * 4; i < n; i += 2048) { const f32x4 c = *(const f32x4*)(C + i); u32x4 o0, o1;
#pragma unroll
        for (int j = 0; j < 4; ++j) { const float x = (ref - c[j]) * INV_SCALE; const unsigned u1 = __float_as_uint(x) & 0xffff0000u; const float r1 = x - __uint_as_float(u1);
            const unsigned u2 = __float_as_uint(r1) & 0xffff0000u; const float r2 = r1 - __uint_as_float(u2); const unsigned u3 = cvtpk(r2, 0.f) & 0xffffu;
            const unsigned w0 = (u1 >> 16) | u2, w1 = u3;
            if (j < 2) { o0[2 * j] = w0; o0[2 * j + 1] = w1; } else { o1[2 * (j - 2)] = w0; o1[2 * (j - 2) + 1] = w1; } }
        *(u32x4*)(cb + (size_t)i * 8) = o0; *(u32x4*)(cb + (size_t)i * 8 + 16) = o1; }
}
#define ROWK(p, k0, rr) ((p) + (size_t)((k0) + (rr)) * KP + sc)
#define VMW() asm volatile("s_waitcnt vmcnt(0)" ::: "memory")
#define VMWN(n) asm volatile("s_waitcnt vmcnt(%0)" :: "i"(n) : "memory")
#define SLOAD_H(Kp, Vp, k0) do { S.st_v0 = load8(ROWK(Vp, k0, sr)); S.st_v1 = load8(ROWK(Vp, k0, 32 + sr));              \
                         S.st_k0 = load8(ROWK(Kp, k0, sr)); S.st_k1 = load8(ROWK(Kp, k0, 32 + sr)); } while (0)
#define OPQ_TID() int t_ = threadIdx.x; asm volatile("" : "+v"(t_)); const int sr_ = t_ >> 4, sc_ = (t_ & 15) * 8
#define SWRITE_HK(bf) do { OPQ_TID(); const int kws_ = KSWZ(sr_, sc_ * 2); *(bf16x8*)(K_lds + (bf) * SHM_K + kws_) = S.st_k0; *(bf16x8*)(K_lds + (bf) * SHM_K + kws_ + 32 * 256) = S.st_k1; } while (0)
#define SWRITE_HV(bf) do { OPQ_TID(); const int vst0_ = v_st(sr_, sc_), vst1_ = v_st(32 + sr_, sc_); *(bf16x8*)(V_lds + (bf) * SHM_V + vst0_) = S.st_v0; *(bf16x8*)(V_lds + (bf) * SHM_V + vst1_) = S.st_v1; } while (0)
#define SWRITE_H(bf) do { SWRITE_HV(bf); SWRITE_HK(bf); } while (0)
__device__ __forceinline__ void fox_prime(const BlockRef& cur, char* lds, char* cbcur, Seam& S) {
    const int tid = threadIdx.x, wid = __builtin_amdgcn_readfirstlane(tid >> 6), lane = tid & 63, r32 = lane & 31, hi = lane >> 5;
    const int sr = tid >> 4, sc = (tid & 15) * 8; char* K_lds = lds + 2 * SHM_V;
    for (int d0 = 0; d0 < 8; ++d0) S.qr[d0] = load8(cur.Q + (size_t)(wid * QBLK + r32) * QP + d0 * 16 + hi * 8);
    SLOAD_H(cur.K, cur.V, cur.P0 + QB - KVBLK); VMW(); SWRITE_HK(0);
    fill_cb(cur.C, cur.P0, cbcur);
    __syncthreads();
}
__device__ __forceinline__ void fox_block(const BlockRef& cur, const BlockRef& nxt, char* lds, char* cbcur, char* cbnxt, Seam& S) {
    const int tid = threadIdx.x, wid = __builtin_amdgcn_readfirstlane(tid >> 6), lane = tid & 63, r32 = lane & 31, hi = lane >> 5;
    const int W = 1 << 30;
    const int NT = (cur.P0 + QB) / KVBLK;
    const int qlo = cur.P0 + wid * QBLK, qm = qlo + r32 - 4 * hi;
    char* V_lds = lds; char* K_lds = lds + 2 * SHM_V;
    float* ws = (float*)(lds + LDS_WS_OFF) + wid * 64; float* li_l = ws, * al_l = ws + 32;
    float m_reg = -1e30f, l_reg = 0; f32x16 o[4] = {};
    const int sr = tid >> 4, sc = (tid & 15) * 8;
    const int vb0 = (int)(uintptr_t)V_lds + v_rd_base(lane);
    const bf16* Kh = cur.K; const bf16* Vh = cur.V;
    const char* cbl = cbcur + 8 * r32;
#define RESC(a) do { if (__any((a) < 1.f)) { if (hi == 0) al_l[r32] = (a); asm volatile("s_waitcnt lgkmcnt(0)" ::: "memory");              \
                     for (int d_ = 0; d_ < 4; ++d_) for (int r = 0; r < 16; ++r) o[d_][r] *= al_l[crow(r, hi)]; } } while (0)
#define KBASE(t) ((NT - 1 - (t)) * KVBLK)
#define MASKT(P0_, P1_, t) do { const int kb_ = KBASE(t); if (kb_ + KVBLK - 1 > qlo) mask_tile(P0_, P1_, qm - kb_, (unsigned)W); } while (0)
    constexpr int NQL = 8;
#define SEAM_K0() do { VMWN(NQL); SWRITE_HK(0); SBAR(); } while (0)
    f32x16 pA0, pA1, pB0, pB1; float mnA, mnB, alA, alB; bf16x8 pa0, pa1, pa2, pa3;
    SWRITE_HV(0); SBAR();
    if (NT > 1) { SLOAD_H(Kh, Vh, KBASE(1)); }
    SBAR(); qkt<0>(pA0, pA1, K_lds, cbl + 8 * KBASE(0), r32, hi, S.qr);
    MASKT(pA0, pA1, 0); partialSM(pA0, pA1, m_reg, mnA, alA);
    if (NT > 1) { VMW(); SWRITE_H(1); }
    __syncthreads();
#define HALF_STEP(PX0, PX1, mnX, alX, PY0, PY1, alY, t, KB, VB, SB) do {                                                      \
        SBAR(); if ((t) + 1 < NT) { SLOAD_H(Kh, Vh, KBASE((t) + 1)); SBAR(); }     \
        qkt<KB>(PX0, PX1, K_lds, cbl + 8 * KBASE(t), r32, hi, S.qr);                                             \
        finishSM(PY0, PY1, alY, l_reg, pa0, pa1, pa2, pa3); SBAR();                                                           \
        pv_tile<VB>(o, vb0, pa0, pa1, pa2, pa3); MASKT(PX0, PX1, (t)); partialSM(PX0, PX1, m_reg, mnX, alX);                                        \
        __syncthreads();                                                                                                      \
        if ((t) + 1 < NT) { VMW(); SWRITE_H(SB); }                                                                          \
        RESC(alX); __syncthreads(); } while (0)
    for (int t = 1; t + 1 < NT; t += 2) {
        HALF_STEP(pB0, pB1, mnB, alB, pA0, pA1, alA, t, 1, 0, 0);
        HALF_STEP(pA0, pA1, mnA, alA, pB0, pB1, alB, t + 1, 0, 1, 1);
    }
    const bool even = (NT & 1) == 0;
    if (even) { SBAR(); qkt<1>(pB0, pB1, K_lds, cbl + 8 * KBASE(NT - 1), r32, hi, S.qr); SBAR(); }
    SLOAD_H(nxt.K, nxt.V, nxt.P0 + QB - KVBLK); SBAR();
#pragma unroll
    for (int d0 = 0; d0 < 8; ++d0) S.qr[d0] = load8(nxt.Q + (size_t)(wid * QBLK + r32) * QP + d0 * 16 + hi * 8);
    SBAR();
    finishSM(pA0, pA1, alA, l_reg, pa0, pa1, pa2, pa3); SBAR();
    pv_tile<0>(o, vb0, pa0, pa1, pa2, pa3);
    if (even) { MASKT(pB0, pB1, NT - 1); partialSM(pB0, pB1, m_reg, mnB, alB); __syncthreads(); RESC(alB);
        finishSM(pB0, pB1, alB, l_reg, pa0, pa1, pa2, pa3); SBAR(); pv_tile<1>(o, vb0, pa0, pa1, pa2, pa3); }
    SBAR(); SEAM_K0();
    if (hi == 0) li_l[r32] = l_reg; asm volatile("s_waitcnt lgkmcnt(0)" ::: "memory");
    float rli[16];
#pragma unroll
    for (int r = 0; r < 16; ++r) rli[r] = __builtin_amdgcn_rcpf(li_l[crow(r, hi)]);
    {
        int ln = lane; asm volatile("" : "+v"(ln)); const int r32e = ln & 31, hie = ln >> 5;
        char* stg = lds + LDS_STG_OFF + wid * 4352;
        bf16* Ow = cur.O + (size_t)(wid * QBLK) * QP; const bf16* Zw = cur.Z + (size_t)(wid * QBLK) * ZP;
#pragma unroll
        for (int half = 0; half < 2; ++half) {
#pragma unroll
            for (int rr = 0; rr < 8; ++rr) { const int r = half * 8 + rr; const int lrow = (rr & 3) + 8 * (rr >> 2) + 4 * hie;
#pragma unroll
                for (int d0 = 0; d0 < 4; ++d0) *(unsigned short*)(stg + lrow * 272 + (d0 * 32 + r32e) * 2) = (unsigned short)cvtpk(o[d0][r] * rli[r], 0.f); }
            asm volatile("s_waitcnt lgkmcnt(0)" ::: "memory");
#pragma unroll
            for (int it = 0; it < 4; ++it) { const int lrow = it * 4 + (ln >> 4), ch = ln & 15, grow = half * 16 + lrow;
                const u32x4 ov = *(const u32x4*)(stg + lrow * 272 + ch * 16); const u32x4 z = *(const u32x4*)(Zw + (size_t)grow * ZP + ch * 8);
                u32x4 w;
                w.x = cvtpk(__uint_as_float(ov.x << 16) * __uint_as_float(z.x << 16), __uint_as_float(ov.x & 0xffff0000u) * __uint_as_float(z.x & 0xffff0000u));
                w.y = cvtpk(__uint_as_float(ov.y << 16) * __uint_as_float(z.y << 16), __uint_as_float(ov.y & 0xffff0000u) * __uint_as_float(z.y & 0xffff0000u));
                w.z = cvtpk(__uint_as_float(ov.z << 16) * __uint_as_float(z.z << 16), __uint_as_float(ov.z & 0xffff0000u) * __uint_as_float(z.z & 0xffff0000u));
                w.w = cvtpk(__uint_as_float(ov.w << 16) * __uint_as_float(z.w << 16), __uint_as_float(ov.w & 0xffff0000u) * __uint_as_float(z.w & 0xffff0000u));
                *(u32x4*)(Ow + (size_t)grow * QP + ch * 8) = w; }
            asm volatile("s_waitcnt lgkmcnt(0)" ::: "memory");
        }
    }
    fill_cb(nxt.C, nxt.P0, cbnxt);
    __syncthreads();
#undef RESC
#undef KBASE
#undef MASKT
#undef SEAM_K0
#undef HALF_STEP
}
#undef ROWK
#undef VMW
#undef VMWN
#undef SLOAD_H
#undef SWRITE_HK
#undef SWRITE_HV
#undef SWRITE_H
#undef OPQ_TID
#undef KSWZ
#undef SBAR

struct Tensors { const bf16* AO; const bf16* K; const bf16* V; const bf16* ZB; const float* C; };
__device__ __forceinline__ BlockRef make_ref(const Tensors& T, int bh, int qb) {
    const int b = bh >> 3, h = bh & 7; const size_t row0 = (size_t)b * SEQ + (size_t)qb * QB;
    BlockRef r;
    r.Q = T.AO + row0 * QP + 1024 + h * D; r.O = (bf16*)r.Q;
    r.K = T.K + (size_t)b * SEQ * KP + h * D; r.V = T.V + (size_t)b * SEQ * KP + h * D;
    r.Z = T.ZB + row0 * ZP + h * D; r.C = T.C + (size_t)bh * SEQ; r.P0 = qb * QB;
    return r;
}
__device__ __forceinline__ void fox_phase(char* lds, const Tensors& T, int vcu, int G) {
    constexpr int total = 64 * 8;
    int L = vcu; if (L >= total) return;
    int pass = 0, par = 0;
    char* cb0 = lds + LDS_CB_OFF;
    BlockRef cur = make_ref(T, L >> 3, L & 7);
    Seam S;
    fox_prime(cur, lds, cb0, S);
    for (;;) {
        const bool more_pass = pass == 0, more_item = L + G < total, last = !more_pass && !more_item;
        int passn = pass + 1, Ln = L;
        if (!more_pass) { passn = 0; Ln = more_item ? L + G : L; }
        const int qbn = passn ? 15 - (Ln & 7) : (Ln & 7);
        const BlockRef nxt = last ? cur : make_ref(T, Ln >> 3, qbn);
        fox_block(cur, nxt, lds, cb0, cb0, S);
        if (last) break;
        cur = nxt; pass = passn; L = Ln; par ^= 1;
    }
}
}

#ifndef MK_N_LAUNCHES
#define MK_N_LAUNCHES 1
#endif
constexpr int N_LAUNCHES = MK_N_LAUNCHES;
constexpr int N_PHASES = 7;
constexpr int NWAVES = 8;
constexpr int BATCH = 8, SEQ = 4096, DM = 1024, T = BATCH * SEQ, NIN = 9224, NH = 8;
constexpr int NP1 = 7168, NG = 2048;
constexpr float EPS = 1e-6f;
constexpr size_t MiB = 1u << 20;
constexpr size_t WS_SSQ = 0, WS_LOGF = 1 * MiB, WS_CC = 2 * MiB, WS_WSM = 3 * MiB;
constexpr size_t WS_W1 = 4 * MiB, WS_WG = 18 * MiB, WS_WAB = 22 * MiB, WS_WO = 26 * MiB;
constexpr size_t WS_AO = 32 * MiB, WS_VA = 160 * MiB, WS_ZA = 224 * MiB, WS_K = 288 * MiB, WS_V = 352 * MiB, WS_ZB = 416 * MiB, WS_END = 480 * MiB;
constexpr int RING_BYTES = 131072, LDS_BYTES = 147456;
static_assert(fa::LDS_BYTES <= LDS_BYTES, "attention LDS");

#define GAS __attribute__((address_space(1)))
#define LAS __attribute__((address_space(3)))
typedef unsigned short bf16;
typedef unsigned v4u __attribute__((ext_vector_type(4)));
typedef float f32x4 __attribute__((ext_vector_type(4)));
typedef short bf16x8 __attribute__((ext_vector_type(8)));
#define LDS_WAIT() asm volatile("s_waitcnt lgkmcnt(0)" ::: "memory")
__device__ __forceinline__ unsigned f2bf(float f) { unsigned u = __builtin_bit_cast(unsigned, f); return (u + 0x7fffu + ((u >> 16) & 1u)) >> 16; }
__device__ __forceinline__ unsigned pk2(float lo, float hi) { return pg8::cvt_pk_bf16_c(lo, hi); }
__device__ __forceinline__ float wave_sum(float v) {
#pragma unroll
    for (int o = 1; o < 64; o <<= 1) v += __shfl_xor(v, o);
    return v;
}
__device__ __forceinline__ void transpose_item(const float* W, int ldw, int nblk, bf16* WT, int ldt, LAS float* scr, int item, int lane) {
    const int kb = item / nblk, nb = item % nblk, k0 = 64 * kb, n0 = 32 * nb;
#pragma unroll 8
    for (int i = 0; i < 32; ++i) { const int kk = 2 * i + (lane >> 5); scr[kk * 33 + (lane & 31)] = W[(size_t)(k0 + kk) * ldw + n0 + (lane & 31)]; }
    LDS_WAIT(); asm volatile("" ::: "memory");
    const int c = lane & 7;
#pragma unroll
    for (int j = 0; j < 4; ++j) { const int n = (lane >> 3) + 8 * j; const LAS float* s = scr + (8 * c) * 33 + n;
        v4u o; o.x = pk2(s[0 * 33], s[1 * 33]); o.y = pk2(s[2 * 33], s[3 * 33]); o.z = pk2(s[4 * 33], s[5 * 33]); o.w = pk2(s[6 * 33], s[7 * 33]);
        *(GAS v4u*)(WT + (size_t)(n0 + n) * ldt + k0 + 8 * c) = o; }
    LDS_WAIT(); asm volatile("" ::: "memory");
}

#define XB_TMO      128
#define XB_XCNT(j)  (256  + 64 * (j))
#define XB_XSUB(j)  (1280 + 64 * (j))
#define XB_XGEN(j)  (2304 + 64 * (j))
#define XB_TOP      3328
#define XB_TOPGEN   3392
#define XCD_BAR_WORDS 3456
#define XB_SPIN_CAP (1u << 18)

__device__ __forceinline__ unsigned xb_ld(unsigned* p)              { return __hip_atomic_load(p, __ATOMIC_RELAXED, __HIP_MEMORY_SCOPE_AGENT); }
__device__ __forceinline__ unsigned xb_add(unsigned* p, unsigned v) { return __hip_atomic_fetch_add(p, v, __ATOMIC_RELAXED, __HIP_MEMORY_SCOPE_AGENT); }
__device__ __forceinline__ unsigned xb_xcc_id() { return (unsigned)__builtin_amdgcn_s_getreg((3 << 11) | 20) & 0xFu; }
#define XB_SPIN(cond, bar) do { unsigned _sp = 0; while (cond) { __builtin_amdgcn_s_sleep(1); \
    if ((++_sp & 255u) == 0u) { if (xb_ld(&(bar)[XB_TMO])) break; if (_sp > XB_SPIN_CAP) { atomicAdd(&(bar)[XB_TMO], 1u); break; } } } } while (0)

struct XcdBarrier {
    unsigned* bar; unsigned x;
    volatile LAS unsigned* st;
};

__device__ __forceinline__ XcdBarrier xcd_barrier_post(unsigned* bar, volatile LAS unsigned* st) {
    XcdBarrier b; b.bar = bar; b.x = xb_xcc_id(); b.st = st;
    if (threadIdx.x == 0) (void)xb_add(&bar[XB_XCNT(b.x)], 1u);
    return b;
}
__device__ __forceinline__ void xcd_barrier_complete(unsigned* bar, unsigned x, unsigned& nloc, unsigned& nx) {
    const unsigned G = gridDim.x * gridDim.y * gridDim.z;
    unsigned sum, cnt, mine, sp = 0u;
    for (;;) {
        sum = 0u; cnt = 0u; mine = 0u;
#pragma unroll
        for (unsigned j = 0; j < 16; ++j) { const unsigned c = xb_ld(&bar[XB_XCNT(j)]); sum += c; cnt += (c > 0u) ? 1u : 0u; mine = (j == x) ? c : mine; }
        if (sum == G) break;
        __builtin_amdgcn_s_sleep(1);
        if ((++sp & 255u) == 0u) { if (xb_ld(&bar[XB_TMO])) break; if (sp > XB_SPIN_CAP) { atomicAdd(&bar[XB_TMO], 1u); break; } }
    }
    nloc = mine > 0u ? mine : 1u; nx = cnt > 0u ? cnt : 1u;
}

__device__ __forceinline__ void xcd_barrier(const XcdBarrier& b) {
    asm volatile("s_waitcnt vmcnt(0)" ::: "memory");
    __syncthreads();
    if (threadIdx.x == 0) {
        unsigned* bar = b.bar;
        __builtin_amdgcn_s_waitcnt(0);
        unsigned nloc = b.st[0], nx = b.st[1];
        if (nloc == 0u) { xcd_barrier_complete(bar, b.x, nloc, nx); b.st[0] = nloc; b.st[1] = nx; }
        const unsigned old = xb_add(&bar[XB_XSUB(b.x)], 1u);
        const unsigned gen = old / nloc;
        if (old + 1u == (gen + 1u) * nloc) {
            __builtin_amdgcn_fence(__ATOMIC_RELEASE, "agent");
            asm volatile("s_waitcnt vmcnt(0)" ::: "memory");
            const unsigned og = xb_add(&bar[XB_TOP], 1u);
            const unsigned tg = og / nx;
            if (og + 1u == (tg + 1u) * nx) xb_add(&bar[XB_TOPGEN], 1u);
            else XB_SPIN(xb_ld(&bar[XB_TOPGEN]) == tg, bar);
            __builtin_amdgcn_fence(__ATOMIC_ACQUIRE, "agent");
            xb_add(&bar[XB_XGEN(b.x)], 1u);
            asm volatile("s_waitcnt vmcnt(0)" ::: "memory");
        } else {
            XB_SPIN(xb_ld(&bar[XB_XGEN(b.x)]) == gen, bar);
            __builtin_amdgcn_fence(__ATOMIC_ACQUIRE, "agent");
            asm volatile("s_waitcnt vmcnt(0)" ::: "memory");
        }
    }
    __syncthreads();
}

constexpr size_t WS_BAR = 512 * 1024, WS_CNT = WS_BAR + 16384; constexpr int BAR_BYTES = 16384 + 128 * 256, MISC_OFF = 147200;
static_assert(XCD_BAR_WORDS * 4 <= 16384 && fa::LDS_BYTES <= MISC_OFF, "barrier words / LDS map");
struct Args { const float* in[13]; float* out; unsigned char* ws; int ph_lo, ph_hi; };

__device__ __forceinline__ void p0_prologue(const Args& a, LAS unsigned char* lds, int vcu, int G, int tid, int lane, int wave) {
    unsigned char* ws = a.ws;
    const float* x = a.in[0]; const float* n1g = a.in[1]; const float* w_in = a.in[2]; const float* w_sp = a.in[5]; const float* b_f = a.in[7];
    const float* wpa = a.in[9]; const float* wpb = a.in[10]; const float* wout = a.in[11];
    bf16* W1t = (bf16*)(ws + WS_W1); bf16* WGt = (bf16*)(ws + WS_WG); bf16* WABt = (bf16*)(ws + WS_WAB); bf16* WOt = (bf16*)(ws + WS_WO);
    bf16* WSM = (bf16*)(ws + WS_WSM); float* ssq = (float*)(ws + WS_SSQ); float* logf_ = (float*)(ws + WS_LOGF);
    bf16* XN = (bf16*)a.out;
    const int gw = vcu * NWAVES + wave, NGW = G * NWAVES, gt = vcu * 512 + tid, NGT = G * 512;
    LAS float* wf = (LAS float*)(lds + 73728);
    for (int i = tid; i < 8192; i += 512) { const int k = i >> 3, h = i & 7; wf[h * 1024 + k] = w_in[(size_t)k * NIN + 7168 + h]; }
    LAS float* scr = (LAS float*)(lds + wave * 8448);
    constexpr int I1 = 16 * (NP1 / 32), IG = 16 * (NG / 32), IS = 16 * 32;
    constexpr int NITEMS = I1 + IG + 3 * IS;
    for (int it = gw; it < NITEMS; it += NGW) {
        int r = it;
        if (r < I1) { transpose_item(w_in, NIN, NP1 / 32, W1t, 1024, scr, r, lane); continue; } r -= I1;
        if (r < IG) { transpose_item(w_in + 7176, NIN, NG / 32, WGt, 1024, scr, r, lane); continue; } r -= IG;
        if (r < IS) { transpose_item(wpa, 1024, 32, WABt, 2048, scr, r, lane); continue; } r -= IS;
        if (r < IS) { transpose_item(wpb, 1024, 32, WABt + 1024, 2048, scr, r, lane); continue; } r -= IS;
        transpose_item(wout, 1024, 32, WOt, 1024, scr, r, lane);
    }
    for (int i = gt; i < 8 * 128 * 128; i += NGT) { const int s = i & 127, t = (i >> 7) & 127; const float v = ((t >> 6) >= (s >> 6)) ? w_sp[i] : 0.f; WSM[i] = (bf16)f2bf(v); }
    for (int i = gt; i < T; i += NGT) ssq[i] = 0.f;
    __syncthreads();
    const GAS f32x4* gp = (const GAS f32x4*)n1g + lane;
    f32x4 gv[4];
#pragma unroll
    for (int j = 0; j < 4; ++j) gv[j] = gp[64 * j];
    f32x4 nv[4];
    const int RPW = (T + NGW - 1) / NGW, mbeg = gw * RPW, mend = (mbeg + RPW < T) ? mbeg + RPW : T;
    if (mbeg < mend) { const GAS f32x4* xr0 = (const GAS f32x4*)(x + (size_t)mbeg * DM) + lane;
#pragma unroll
        for (int j = 0; j < 4; ++j) nv[j] = xr0[64 * j]; }
    for (int m = mbeg; m < mend; ++m) {
        f32x4 v[4]; float s2 = 0.f;
#pragma unroll
        for (int j = 0; j < 4; ++j) { v[j] = nv[j]; s2 += (v[j].x * v[j].x + v[j].y * v[j].y) + (v[j].z * v[j].z + v[j].w * v[j].w); }
        if (m + 1 < mend) { const GAS f32x4* xr = (const GAS f32x4*)(x + (size_t)(m + 1) * DM) + lane;
#pragma unroll
            for (int j = 0; j < 4; ++j) nv[j] = xr[64 * j]; }
        const float rstd = 1.0f / sqrtf(wave_sum(s2) * (1.f / DM) + EPS);
#pragma unroll
        for (int j = 0; j < 4; ++j) v[j] = v[j] * rstd * gv[j];
        GAS unsigned long long* o8 = (GAS unsigned long long*)(XN + (size_t)m * DM) + lane;
#pragma unroll
        for (int j = 0; j < 4; ++j) o8[64 * j] = (unsigned long long)pk2(v[j].x, v[j].y) | ((unsigned long long)pk2(v[j].z, v[j].w) << 32);
        float f[8];
#pragma unroll
        for (int h = 0; h < 8; ++h) { float acc = 0.f;
#pragma unroll
            for (int j = 0; j < 4; ++j) { const f32x4 w = *(const LAS f32x4*)(wf + h * 1024 + 256 * j + 4 * lane); acc += (v[j].x * w.x + v[j].y * w.y) + (v[j].z * w.z + v[j].w * w.w); }
            f[h] = acc; }
        float q4[4], q2[2], fz;
        { const bool b = (lane & 1) != 0;
#pragma unroll
          for (int k = 0; k < 4; ++k) { const float keep = b ? f[2 * k + 1] : f[2 * k], give = b ? f[2 * k] : f[2 * k + 1]; q4[k] = keep + __shfl_xor(give, 1); } }
        { const bool b = (lane & 2) != 0;
#pragma unroll
          for (int k = 0; k < 2; ++k) { const float keep = b ? q4[2 * k + 1] : q4[2 * k], give = b ? q4[2 * k] : q4[2 * k + 1]; q2[k] = keep + __shfl_xor(give, 2); } }
        { const bool b = (lane & 4) != 0; const float keep = b ? q2[1] : q2[0], give = b ? q2[0] : q2[1]; fz = keep + __shfl_xor(give, 4); }
        fz += __shfl_xor(fz, 8); fz += __shfl_xor(fz, 16); fz += __shfl_xor(fz, 32);
        if (lane < 8) { const float z = fz + b_f[lane]; const float ls = fminf(z, 0.f) - log1pf(expf(-fabsf(z)));
            const int b = m >> 12, s = m & 4095; logf_[((size_t)(b * NH + lane) << 12) + s] = ls; }
    }
}
__device__ __forceinline__ void cumsum_bh(const float* logf_, float* cc, int bh, LAS unsigned char* lds, int tid, int lane, int wave) {
    LAS float* wt = (LAS float*)lds;
    const float* src = logf_ + (size_t)bh * SEQ + tid * 8; float* dst = cc + (size_t)bh * SEQ + tid * 8;
    f32x4 a = *(const f32x4*)src, b = *(const f32x4*)(src + 4);
    a.y += a.x; a.z += a.y; a.w += a.z; b.x += a.w; b.y += b.x; b.z += b.y; b.w += b.z;
    float tot = b.w, inc = tot;
#pragma unroll
    for (int o = 1; o < 64; o <<= 1) { const float n = __shfl_up(inc, o); if (lane >= o) inc += n; }
    if (lane == 63) wt[wave] = inc;
    __syncthreads();
    float base = inc - tot;
    for (int w = 0; w < wave; ++w) base += wt[w];
    a = a + base; b = b + base;
    *(f32x4*)dst = a; *(f32x4*)(dst + 4) = b;
    __syncthreads();
}
constexpr int VN_PITCH = 260, YT_PITCH = 528, YT_OFF = 128 * VN_PITCH;
__device__ __forceinline__ void sgu_item(LAS unsigned char* lds, const bf16* VA, bf16* AO, const bf16* ZA, const bf16* WSM, const float* ln_g, const float* ln_b, const float* b_sp,
                                         int rb, int g, int tid, int lane, int wave, v4u (&vin)[4], int rbn, int gn, bool has_next) {
    const int r0 = rb * 128;
    v4u ureg[4], zreg[4];
    {
        const int row = tid >> 2, q = tid & 3;
        const v4u* up0 = (const v4u*)(AO + (size_t)(r0 + row) * 2048 + g * 128 + q * 32);
        const v4u* zp0 = (const v4u*)(ZA + (size_t)(r0 + row) * 1024 + g * 128 + q * 32);
#pragma unroll
        for (int i = 0; i < 4; ++i) { ureg[i] = up0[i]; zreg[i] = zp0[i]; }
    }
    {
        const int row = tid >> 2, q = tid & 3;
        float v[32];
#pragma unroll
        for (int i = 0; i < 4; ++i) { const v4u w = vin[i];
            v[8 * i + 0] = __uint_as_float(w.x << 16); v[8 * i + 1] = __uint_as_float(w.x & 0xffff0000u); v[8 * i + 2] = __uint_as_float(w.y << 16); v[8 * i + 3] = __uint_as_float(w.y & 0xffff0000u);
            v[8 * i + 4] = __uint_as_float(w.z << 16); v[8 * i + 5] = __uint_as_float(w.z & 0xffff0000u); v[8 * i + 6] = __uint_as_float(w.w << 16); v[8 * i + 7] = __uint_as_float(w.w & 0xffff0000u); }
        float s = 0.f;
#pragma unroll
        for (int i = 0; i < 32; ++i) s += v[i];
        s += __shfl_xor(s, 1); s += __shfl_xor(s, 2);
        const float mu = s * (1.f / 128.f); float s2 = 0.f;
#pragma unroll
        for (int i = 0; i < 32; ++i) { v[i] -= mu; s2 += v[i] * v[i]; }
        s2 += __shfl_xor(s2, 1); s2 += __shfl_xor(s2, 2);
        const float rstd = 1.0f / sqrtf(s2 * (1.f / 128.f) + EPS);
        const f32x4* gp = (const f32x4*)(ln_g + g * 128 + q * 32); const f32x4* bp = (const f32x4*)(ln_b + g * 128 + q * 32);
        LAS unsigned* dst = (LAS unsigned*)(lds + row * VN_PITCH + q * 64);
#pragma unroll
        for (int i = 0; i < 8; ++i) { const f32x4 gg = gp[i], bb = bp[i];
            dst[2 * i] = pk2(v[4 * i] * rstd * gg.x + bb.x, v[4 * i + 1] * rstd * gg.y + bb.y);
            dst[2 * i + 1] = pk2(v[4 * i + 2] * rstd * gg.z + bb.z, v[4 * i + 3] * rstd * gg.w + bb.w); }
    }
    __syncthreads();
    if (has_next) {
        const int row = tid >> 2, q = tid & 3;
        const v4u* vp = (const v4u*)(VA + (size_t)(rbn * 128 + row) * 1024 + gn * 128 + q * 32);
#pragma unroll
        for (int i = 0; i < 4; ++i) vin[i] = vp[i];
    }
    {
        const int fr = lane & 15, fq = lane >> 4, c = 16 * wave + fr;
        bf16x8 X[4];
#pragma unroll
        for (int kb = 0; kb < 4; ++kb) {
            const LAS unsigned short* p = (const LAS unsigned short*)(lds + (32 * kb + 8 * fq) * VN_PITCH + c * 2);
#pragma unroll
            for (int j = 0; j < 8; ++j) X[kb][j] = (short)p[j * (VN_PITCH / 2)];
        }
        const bf16* wg = WSM + (size_t)g * 16384 + fr * 128 + 8 * fq;
        f32x4 acc[8];
#pragma unroll
        for (int m = 0; m < 8; ++m) { acc[m] = (f32x4){0.f, 0.f, 0.f, 0.f};
#pragma unroll
            for (int kb = 0; kb < 4; ++kb) { if (m < 4 && kb >= 2) continue;
                const bf16x8 Y = *(const bf16x8*)(wg + m * 2048 + kb * 32);
                acc[m] = __builtin_amdgcn_mfma_f32_16x16x32_bf16(X[kb], Y, acc[m], 0, 0, 0); } }
#pragma unroll
        for (int m = 0; m < 8; ++m) { const int t = 16 * m + fr; const float bs = b_sp[g * 128 + t];
            *(LAS f32x4*)(lds + YT_OFF + t * YT_PITCH + (16 * wave + 4 * fq) * 4) = acc[m] + bs; }
    }
    __syncthreads();
    {
        const int row = tid >> 2, q = tid & 3;
        v4u* up = (v4u*)(AO + (size_t)(r0 + row) * 2048 + g * 128 + q * 32);
        const LAS f32x4* yp = (const LAS f32x4*)(lds + YT_OFF + row * YT_PITCH + q * 128);
#pragma unroll
        for (int i = 0; i < 4; ++i) { const v4u u = ureg[i], z = zreg[i]; const f32x4 y0 = yp[2 * i], y1 = yp[2 * i + 1];
            v4u o;
            o.x = pk2(__uint_as_float(u.x << 16) * y0.x * __uint_as_float(z.x << 16), __uint_as_float(u.x & 0xffff0000u) * y0.y * __uint_as_float(z.x & 0xffff0000u));
            o.y = pk2(__uint_as_float(u.y << 16) * y0.z * __uint_as_float(z.y << 16), __uint_as_float(u.y & 0xffff0000u) * y0.w * __uint_as_float(z.y & 0xffff0000u));
            o.z = pk2(__uint_as_float(u.z << 16) * y1.x * __uint_as_float(z.z << 16), __uint_as_float(u.z & 0xffff0000u) * y1.y * __uint_as_float(z.z & 0xffff0000u));
            o.w = pk2(__uint_as_float(u.w << 16) * y1.z * __uint_as_float(z.w << 16), __uint_as_float(u.w & 0xffff0000u) * y1.w * __uint_as_float(z.w & 0xffff0000u));
            up[i] = o; }
    }
}


__global__ void __launch_bounds__(NWAVES * 64, 2) fwd_mega(Args args) {
    extern __shared__ __attribute__((aligned(16))) unsigned char lds_raw[];
    LAS unsigned char* lds = (LAS unsigned char*)lds_raw;
    __builtin_assume(__builtin_amdgcn_workitem_id_y() == 0); __builtin_assume(__builtin_amdgcn_workitem_id_z() == 0);
    const int wave = __builtin_amdgcn_readfirstlane(threadIdx.x >> 6);
#define PH_IDS() int tid = threadIdx.x; asm volatile("" : "+v"(tid)); const int lane = tid & 63
    const int G = gridDim.x; const int bx = blockIdx.x; const int vcu = (G % 8 == 0) ? (bx % 8) * (G / 8) + bx / 8 : bx;
    unsigned char* ws = args.ws;
    const int lo = args.ph_lo, hi = args.ph_hi;
#define IN(k) (lo <= (k) && (k) < hi)
#define SEAM(k) do { if (IN(k) && IN((k) + 1)) { if ((k) == 0) cg::this_grid().sync(); else xcd_barrier(xbar); } } while (0)
    { volatile LAS unsigned* m_ = (volatile LAS unsigned*)(lds + MISC_OFF); if (threadIdx.x < 16) m_[threadIdx.x] = 0u; }
    __syncthreads();
    if (lo == 0 && blockIdx.x == 0) { unsigned* bz = (unsigned*)(ws + WS_BAR); for (int i = threadIdx.x; i < BAR_BYTES / 4; i += NWAVES * 64) bz[i] = 0u; }
    XcdBarrier xbar; xbar.bar = (unsigned*)(ws + WS_BAR); xbar.x = 0; xbar.st = (volatile LAS unsigned*)(lds + MISC_OFF);
    bf16* XN = (bf16*)args.out;
    bf16* AO = (bf16*)(ws + WS_AO); bf16* VA = (bf16*)(ws + WS_VA); bf16* ZA = (bf16*)(ws + WS_ZA); bf16* KB = (bf16*)(ws + WS_K); bf16* VB = (bf16*)(ws + WS_V); bf16* ZB = (bf16*)(ws + WS_ZB);
    bf16* GA = VA; bf16* GB = ZA; bf16* MG = KB;
    float* ssq = (float*)(ws + WS_SSQ); float* logf_ = (float*)(ws + WS_LOGF); float* cc = (float*)(ws + WS_CC);

    if (IN(0)) { PH_IDS(); p0_prologue(args, lds, vcu, G, tid, lane, wave); __syncthreads(); }
    SEAM(0);
    xbar = xcd_barrier_post((unsigned*)(ws + WS_BAR), (volatile LAS unsigned*)(lds + MISC_OFF));
    if (IN(1)) {
        { PH_IDS(); for (int bh = vcu; bh < BATCH * NH; bh += G) cumsum_bh(logf_, cc, bh, lds, tid, lane, wave); }
        pg8::Gemm g{XN, (const bf16*)(ws + WS_W1), T, NP1, DM}; pg8::StaticOrder S; S.init(T, NP1, G, bx);
        pg8::EpiP1 E{AO, VA, ZA, KB, VB, ZB};
        pg8::gemm_phase<pg8::EpiP1, pg8::StaticOrder, true, true>(lds, g, S, E);
    }
    SEAM(1);
    if (IN(2)) {
        const bf16* WSM = (const bf16*)(ws + WS_WSM);
        const fa::Tensors FT{AO, KB, VB, ZB, cc};
        if (vcu & 1) { fa::fox_phase((char*)lds_raw, FT, vcu, G); __syncthreads(); { PH_IDS(); v4u vin[4];
                if (vcu < 2048) { const v4u* vp = (const v4u*)(VA + (size_t)((vcu >> 3) * 128 + (tid >> 2)) * 1024 + (vcu & 7) * 128 + (tid & 3) * 32);
#pragma unroll
                    for (int i = 0; i < 4; ++i) vin[i] = vp[i]; }
                for (int it = vcu; it < 2048; it += G) { const int itn = it + G; sgu_item(lds, VA, AO, ZA, WSM, args.in[3], args.in[4], args.in[6], it >> 3, it & 7, tid, lane, wave, vin, itn >> 3, itn & 7, itn < 2048); } } }
        else { { PH_IDS(); v4u vin[4];
                if (vcu < 2048) { const v4u* vp = (const v4u*)(VA + (size_t)((vcu >> 3) * 128 + (tid >> 2)) * 1024 + (vcu & 7) * 128 + (tid & 3) * 32);
#pragma unroll
                    for (int i = 0; i < 4; ++i) vin[i] = vp[i]; }
                for (int it = vcu; it < 2048; it += G) { const int itn = it + G; sgu_item(lds, VA, AO, ZA, WSM, args.in[3], args.in[4], args.in[6], it >> 3, it & 7, tid, lane, wave, vin, itn >> 3, itn & 7, itn < 2048); } } __syncthreads(); fa::fox_phase((char*)lds_raw, FT, vcu, G); }
    }
    SEAM(2);
    if (IN(3)) {
        pg8::Gemm g{XN, (const bf16*)(ws + WS_WG), T, NG, DM}; pg8::StaticOrder S; S.init(T, NG, G, bx);
        pg8::EpiGate E{GA, GB, args.in[8]};
        pg8::gemm_phase<pg8::EpiGate, pg8::StaticOrder, true, true>(lds, g, S, E);
    }
    if (G != 256) SEAM(3);
    if (IN(4)) {
        pg8::Gemm g{AO, (const bf16*)(ws + WS_WAB), T, DM, 2 * DM}; pg8::StaticOrder S; S.init(T, DM, G, bx);
        pg8::EpiMerged E{GA, GB, MG};
        pg8::gemm_phase<pg8::EpiMerged, pg8::StaticOrder, true, true>(lds, g, S, E);
    }
    SEAM(4);
    if (IN(5)) {
        pg8::Gemm g{MG, (const bf16*)(ws + WS_WO), T, DM, DM}; pg8::StaticOrder S; S.init(T, DM, G, bx);
        if (N_LAUNCHES == 1) { pg8::EpiOutNorm E{args.in[0], args.out, ssq, (unsigned*)(ws + WS_CNT), args.in[12], EPS};
            pg8::gemm_phase<pg8::EpiOutNorm, pg8::StaticOrder, true, true>(lds, g, S, E); }
        else { pg8::EpiOut E{args.in[0], args.out, ssq};
            pg8::gemm_phase<pg8::EpiOut, pg8::StaticOrder, true, true>(lds, g, S, E); }
    }
    if (N_LAUNCHES != 1) SEAM(5);
    if (IN(6) && N_LAUNCHES != 1) {
        PH_IDS(); const float* nfg = args.in[12];
        const int gw = vcu * NWAVES + wave, NGW = G * NWAVES;
        const GAS f32x4* gp = (const GAS f32x4*)nfg + lane;
        f32x4 gv[4];
#pragma unroll
        for (int j = 0; j < 4; ++j) gv[j] = gp[64 * j];
        for (int m = gw; m < T; m += NGW) {
            GAS f32x4* hr = (GAS f32x4*)(args.out + (size_t)m * DM) + lane;
            const float rstd = 1.0f / sqrtf(ssq[m] * (1.f / DM) + EPS);
#pragma unroll
            for (int j = 0; j < 4; ++j) { const f32x4 h = hr[64 * j]; hr[64 * j] = h * rstd * gv[j]; }
        }
    }
#undef IN
#undef SEAM
}


extern "C" void kernel_launch(void* const* d_in, const int* in_sizes, int n_in, void* d_out, int out_size, void* d_ws, size_t ws_size, hipStream_t stream) {
    static int grid = 0;
    if (grid == 0) {
        if (n_in != 13 || in_sizes[0] != T * DM || out_size != T * DM || ws_size < WS_END) { fprintf(stderr, "kernel_launch: shape/workspace mismatch (n_in %d, in0 %d, out %d, ws %zu)\n", n_in, n_in > 0 ? in_sizes[0] : -1, out_size, ws_size); grid = -1; return; }
        int dev = 0, cus = 0, per_cu = 0;
        if (hipGetDevice(&dev) != hipSuccess || hipDeviceGetAttribute(&cus, hipDeviceAttributeMultiprocessorCount, dev) != hipSuccess) { grid = -1; return; }
        if (hipFuncSetAttribute((const void*)fwd_mega, hipFuncAttributeMaxDynamicSharedMemorySize, LDS_BYTES) != hipSuccess) { fprintf(stderr, "kernel_launch: hipFuncSetAttribute failed\n"); grid = -1; return; }
        if (hipOccupancyMaxActiveBlocksPerMultiprocessor(&per_cu, (const void*)fwd_mega, NWAVES * 64, LDS_BYTES) != hipSuccess || per_cu < 1) { fprintf(stderr, "kernel_launch: occupancy query says %d\n", per_cu); per_cu = 1; }
        (void)hipGetLastError();
        grid = cus;
    }
    if (grid < 0) return;
    Args a{};
    for (int i = 0; i < 13; ++i) a.in[i] = (const float*)d_in[i];
    a.out = (float*)d_out; a.ws = (unsigned char*)d_ws;
    if (N_LAUNCHES == 1) {
        a.ph_lo = 0; a.ph_hi = N_PHASES;
        void* kargs[] = {&a};
        hipError_t e = hipLaunchCooperativeKernel((const void*)fwd_mega, dim3(grid), dim3(NWAVES * 64), kargs, LDS_BYTES, stream);
        if (e != hipSuccess) fprintf(stderr, "kernel_launch: cooperative launch failed: %s (grid %d)\n", hipGetErrorString(e), grid);
    } else {
        for (int p = 0; p < N_PHASES; ++p) { a.ph_lo = p; a.ph_hi = p + 1; hipLaunchKernelGGL(fwd_mega, dim3(grid), dim3(NWAVES * 64), LDS_BYTES, stream, a); }
    }
}
```

```cpp
#include <hip/hip_runtime.h>
#include <hip/hip_cooperative_groups.h>
#include <cstdio>
#include <cstdint>
#include <cmath>
namespace cg = cooperative_groups;
namespace pg8 {
#define PG8_LAS __attribute__((address_space(3)))
typedef unsigned short bf16_t;
typedef short bf16x8 __attribute__((ext_vector_type(8)));
typedef float f32x4 __attribute__((ext_vector_type(4)));
typedef unsigned u32x4 __attribute__((ext_vector_type(4)));
constexpr int BM = 256, BK = 64, HALF = 128, HTB = HALF * BK * 2  , STAGE_BYTES = 8 * HTB, NXCD = 8, WGM = 8;

__host__ __device__ __forceinline__ int lds_byte(int r, int c) { const int st = (r >> 4) * 2 + (c >> 5), rr = r & 15, cc = c & 31, ob = rr * 64 + cc * 2; return st * 1024 + (ob ^ (((ob >> 9) & 1) << 5)); }
__host__ __device__ __forceinline__ void stage_rc(int b, int& R, int& C) { const int st = b / 1024, sb = b % 1024, swz = sb ^ (((sb >> 9) & 1) << 5); R = (st >> 1) * 16 + swz / 64; C = (st & 1) * 32 + (swz % 64) / 2; }
__host__ __device__ __forceinline__ int perm32(int rho) { const int n = rho >> 4, i = rho & 15; return 8 * (i >> 2) + 4 * n + (i & 3); }

struct Unit { int pm, pn; };
struct Gemm { const bf16_t* A; const bf16_t* Bt; int M, N, K; };

struct StaticOrder {
    int nM, nN, nwg, G, c;
    __host__ __device__ void init(int M, int N, int G_, int c_) { nM = M / BM; nN = N / BM; nwg = nM * nN; G = G_; c = c_; }
    __host__ __device__ bool next(int i, Unit& u) const {
        const long L = (long)i * G + c; if (L >= nwg) return false;
        int wgid = (int)L; { const int q = nwg / NXCD, r = nwg % NXCD, xcd = wgid % NXCD, off = wgid / NXCD; wgid = (xcd < r ? xcd * (q + 1) : r * (q + 1) + (xcd - r) * q) + off; }
        const int nig = WGM * nN, gid = wgid / nig, fm = gid * WGM, gsz = (nM - fm) < WGM ? (nM - fm) : WGM;
        u.pm = fm + ((wgid % nig) % gsz); u.pn = (wgid % nig) / gsz; return true;
    }
    __device__ __forceinline__ void a_ready(const Unit&) const {}
    __device__ __forceinline__ void done(const Unit&) const {}
};

__device__ __forceinline__ unsigned cvt_pk_bf16(float lo, float hi) { unsigned r; asm volatile("v_cvt_pk_bf16_f32 %0, %1, %2" : "=v"(r) : "v"(lo), "v"(hi)); return r; }
typedef float f32x2 __attribute__((ext_vector_type(2)));

__device__ __forceinline__ float silu_f(float v) { return v * __builtin_amdgcn_rcpf(1.0f + __builtin_amdgcn_exp2f(-1.4426950408889634f * v)); }
__device__ __forceinline__ float sigm_f(float v) { return __builtin_amdgcn_rcpf(1.0f + __builtin_amdgcn_exp2f(-1.4426950408889634f * v)); }
typedef float f32x2c_t __attribute__((ext_vector_type(2))); typedef __bf16 bf16x2c_t __attribute__((ext_vector_type(2)));
__device__ __forceinline__ unsigned cvt_pk_bf16_c(float lo, float hi) { f32x2c_t v = {lo, hi}; bf16x2c_t b = __builtin_convertvector(v, bf16x2c_t); return __builtin_bit_cast(unsigned, b); }
__device__ __forceinline__ float bf_lo(unsigned w) { return __uint_as_float(w << 16); }
__device__ __forceinline__ float bf_hi(unsigned w) { return __uint_as_float(w & 0xffff0000u); }

struct EpiP1 {
    static constexpr bool PERM = true, AFTER_DRAIN = false, HAS_MID = false; static constexpr int MID_T = -1;
    bf16_t *AO, *VA, *ZA, *KB, *VB, *ZB;
    __device__ __forceinline__ void mid(f32x4 (&)[2][2][4][2], const Unit&, int, int, int, int) const {}
    __device__ __forceinline__ void operator()(const f32x4 (&acc)[2][2][4][2], const Unit& u, int wr, int wc, int fr, int fq) const {
        const int g = u.pn >> 2, cin = (u.pn & 3) * BM;
        bf16_t* base = g == 0 ? AO : g == 1 ? VA : g == 2 ? ZA : g == 3 ? AO + 1024 : g == 4 ? KB : g == 5 ? VB : ZB;
        const int ldc = (g == 0 || g == 3) ? 2048 : 1024;
        const bool act = (g == 2 || g == 6);
        const int row0 = u.pm * BM + wr * 64 + fr, col0 = cin + wc * 32 + 8 * fq;
#pragma unroll
        for (int ai = 0; ai < 2; ++ai)
#pragma unroll
            for (int m = 0; m < 4; ++m) { bf16_t* rowp = base + (size_t)(row0 + ai * HALF + m * 16) * ldc + col0;
#pragma unroll
                for (int bj = 0; bj < 2; ++bj) { f32x4 v0 = acc[ai][bj][m][0], v1 = acc[ai][bj][m][1];
                    if (act) {
#pragma unroll
                        for (int e = 0; e < 4; ++e) { v0[e] = silu_f(v0[e]); v1[e] = silu_f(v1[e]); } }
                    u32x4 w; w.x = cvt_pk_bf16(v0[0], v0[1]); w.y = cvt_pk_bf16(v0[2], v0[3]); w.z = cvt_pk_bf16(v1[0], v1[1]); w.w = cvt_pk_bf16(v1[2], v1[3]);
                    *(u32x4*)(rowp + bj * HALF) = w; } }
    }
};
struct EpiGate {
    static constexpr bool PERM = true, AFTER_DRAIN = false, HAS_MID = false; static constexpr int MID_T = -1;
    bf16_t *GA, *GB; const float* bias;
    __device__ __forceinline__ void mid(f32x4 (&)[2][2][4][2], const Unit&, int, int, int, int) const {}
    __device__ __forceinline__ void operator()(const f32x4 (&acc)[2][2][4][2], const Unit& u, int wr, int wc, int fr, int fq) const {
        const int g = u.pn >> 2, cin = (u.pn & 3) * BM;
        bf16_t* base = g == 0 ? GA : GB;
        const int row0 = u.pm * BM + wr * 64 + fr, col0 = cin + wc * 32 + 8 * fq, bcol0 = u.pn * BM + wc * 32 + 8 * fq;
        f32x4 bv[2][2];
#pragma unroll
        for (int bj = 0; bj < 2; ++bj)
#pragma unroll
            for (int n = 0; n < 2; ++n) bv[bj][n] = *(const f32x4*)(bias + bcol0 + bj * HALF + 4 * n);
#pragma unroll
        for (int ai = 0; ai < 2; ++ai)
#pragma unroll
            for (int m = 0; m < 4; ++m) { bf16_t* rowp = base + (size_t)(row0 + ai * HALF + m * 16) * 1024 + col0;
#pragma unroll
                for (int bj = 0; bj < 2; ++bj) { f32x4 v0 = acc[ai][bj][m][0] + bv[bj][0], v1 = acc[ai][bj][m][1] + bv[bj][1];
#pragma unroll
                    for (int e = 0; e < 4; ++e) { v0[e] = sigm_f(v0[e]); v1[e] = sigm_f(v1[e]); }
                    u32x4 w; w.x = cvt_pk_bf16_c(v0[0], v0[1]); w.y = cvt_pk_bf16_c(v0[2], v0[3]); w.z = cvt_pk_bf16_c(v1[0], v1[1]); w.w = cvt_pk_bf16_c(v1[2], v1[3]);
                    *(u32x4*)(rowp + bj * HALF) = w; } }
    }
};
struct EpiMerged {
    static constexpr bool PERM = true, AFTER_DRAIN = false, HAS_MID = true; static constexpr int MID_T = 16;
    const bf16_t *GA, *GB; bf16_t* MG;
    __device__ __forceinline__ void mid(f32x4 (&acc)[2][2][4][2], const Unit& u, int wr, int wc, int fr, int fq) const {
        asm volatile("" : "+v"(fr), "+v"(fq));
        const int row0 = u.pm * BM + wr * 64 + fr, col0 = u.pn * BM + wc * 32 + 8 * fq;
#pragma unroll
        for (int ai = 0; ai < 2; ++ai)
#pragma unroll
            for (int m = 0; m < 4; ++m) { const size_t off = (size_t)(row0 + ai * HALF + m * 16) * 1024 + col0;
#pragma unroll
                for (int bj = 0; bj < 2; ++bj) { const u32x4 a = *(const u32x4*)(GA + off + bj * HALF), b = *(const u32x4*)(GB + off + bj * HALF);
                    f32x4 r0, r1;
                    r0[0] = bf_lo(a.x) * __builtin_amdgcn_rcpf(bf_lo(b.x)); r0[1] = bf_hi(a.x) * __builtin_amdgcn_rcpf(bf_hi(b.x));
                    r0[2] = bf_lo(a.y) * __builtin_amdgcn_rcpf(bf_lo(b.y)); r0[3] = bf_hi(a.y) * __builtin_amdgcn_rcpf(bf_hi(b.y));
                    r1[0] = bf_lo(a.z) * __builtin_amdgcn_rcpf(bf_lo(b.z)); r1[1] = bf_hi(a.z) * __builtin_amdgcn_rcpf(bf_hi(b.z));
                    r1[2] = bf_lo(a.w) * __builtin_amdgcn_rcpf(bf_lo(b.w)); r1[3] = bf_hi(a.w) * __builtin_amdgcn_rcpf(bf_hi(b.w));
                    acc[ai][bj][m][0] *= r0; acc[ai][bj][m][1] *= r1; }
                if (m & 1) asm volatile("" ::: "memory"); }
    }
    __device__ __forceinline__ void operator()(const f32x4 (&acc)[2][2][4][2], const Unit& u, int wr, int wc, int fr, int fq) const {
        const int row0 = u.pm * BM + wr * 64 + fr, col0 = u.pn * BM + wc * 32 + 8 * fq;
#pragma unroll
        for (int ai = 0; ai < 2; ++ai)
#pragma unroll
            for (int m = 0; m < 4; ++m) { const size_t off = (size_t)(row0 + ai * HALF + m * 16) * 1024 + col0;
#pragma unroll
                for (int bj = 0; bj < 2; ++bj) { const u32x4 b = *(const u32x4*)(GB + off + bj * HALF);
                    const f32x4 v0 = acc[ai][bj][m][0], v1 = acc[ai][bj][m][1];
                    u32x4 w; w.x = cvt_pk_bf16(v0[0] * bf_lo(b.x), v0[1] * bf_hi(b.x)); w.y = cvt_pk_bf16(v0[2] * bf_lo(b.y), v0[3] * bf_hi(b.y));
                    w.z = cvt_pk_bf16(v1[0] * bf_lo(b.z), v1[1] * bf_hi(b.z)); w.w = cvt_pk_bf16(v1[2] * bf_lo(b.w), v1[3] * bf_hi(b.w));
                    *(u32x4*)(MG + off + bj * HALF) = w; } }
    }
};

struct EpiOutNorm {
    static constexpr bool PERM = false, AFTER_DRAIN = false, HAS_MID = false; static constexpr int MID_T = -1;
    const float* x; float* out; float* ssq; unsigned* cnt; const float* gw; float eps;
    __device__ __forceinline__ void mid(f32x4 (&)[2][2][4][2], const Unit&, int, int, int, int) const {}
    __device__ __forceinline__ void operator()(f32x4 (&acc)[2][2][4][2], const Unit& u, int wr, int wc, int fr, int fq) const {
        const int row0 = u.pm * BM + wr * 64 + fr, col0 = u.pn * BM + wc * 32 + 4 * fq;
#pragma unroll
        for (int ai = 0; ai < 2; ++ai)
#pragma unroll
            for (int m = 0; m < 4; ++m) { const int row = row0 + ai * HALF + m * 16; const size_t off = (size_t)row * 1024 + col0; float s = 0.f;
#pragma unroll
                for (int bj = 0; bj < 2; ++bj)
#pragma unroll
                    for (int n = 0; n < 2; ++n) { const f32x4 xv = *(const f32x4*)(x + off + bj * HALF + n * 16); const f32x4 h = xv + acc[ai][bj][m][n]; acc[ai][bj][m][n] = h;
                        s += (h[0] * h[0] + h[1] * h[1]) + (h[2] * h[2] + h[3] * h[3]); }
                s += __shfl_xor(s, 16); s += __shfl_xor(s, 32);
                if (fq == 0) __hip_atomic_fetch_add(ssq + row, s, __ATOMIC_RELAXED, __HIP_MEMORY_SCOPE_AGENT);
                asm volatile("" ::: "memory"); }
        asm volatile("s_waitcnt vmcnt(0)" ::: "memory");
        unsigned* c = cnt + 64 * u.pm;
        if ((threadIdx.x & 63) == 0) __hip_atomic_fetch_add(c, 1u, __ATOMIC_RELAXED, __HIP_MEMORY_SCOPE_AGENT);
        { unsigned sp = 0; while ((unsigned)__builtin_amdgcn_readfirstlane(__hip_atomic_load(c, __ATOMIC_RELAXED, __HIP_MEMORY_SCOPE_AGENT)) < 32u) { __builtin_amdgcn_s_sleep(2); if (++sp > (1u << 22)) break; } }
        asm volatile("" ::: "memory");
        f32x4 gv[2][2];
#pragma unroll
        for (int bj = 0; bj < 2; ++bj)
#pragma unroll
            for (int n = 0; n < 2; ++n) gv[bj][n] = *(const f32x4*)(gw + col0 + bj * HALF + n * 16);
#pragma unroll
        for (int ai = 0; ai < 2; ++ai)
#pragma unroll
            for (int m = 0; m < 4; ++m) { const int row = row0 + ai * HALF + m * 16; const size_t off = (size_t)row * 1024 + col0;
                const float ss = __hip_atomic_load(ssq + row, __ATOMIC_RELAXED, __HIP_MEMORY_SCOPE_AGENT);
                const float rstd = 1.0f / sqrtf(ss * (1.0f / 1024.0f) + eps);
#pragma unroll
                for (int bj = 0; bj < 2; ++bj)
#pragma unroll
                    for (int n = 0; n < 2; ++n) *(f32x4*)(out + off + bj * HALF + n * 16) = acc[ai][bj][m][n] * rstd * gv[bj][n]; }
    }
};
struct EpiOut {
    static constexpr bool PERM = false, AFTER_DRAIN = false, HAS_MID = false; static constexpr int MID_T = -1;
    const float* x; float* out; float* ssq;
    __device__ __forceinline__ void mid(f32x4 (&)[2][2][4][2], const Unit&, int, int, int, int) const {}
    __device__ __forceinline__ void operator()(const f32x4 (&acc)[2][2][4][2], const Unit& u, int wr, int wc, int fr, int fq) const {
        const int row0 = u.pm * BM + wr * 64 + fr, col0 = u.pn * BM + wc * 32 + 4 * fq;
#pragma unroll
        for (int ai = 0; ai < 2; ++ai)
#pragma unroll
            for (int m = 0; m < 4; ++m) { const int row = row0 + ai * HALF + m * 16; const size_t off = (size_t)row * 1024 + col0; float s = 0.f;
#pragma unroll
                for (int bj = 0; bj < 2; ++bj)
#pragma unroll
                    for (int n = 0; n < 2; ++n) { const f32x4 xv = *(const f32x4*)(x + off + bj * HALF + n * 16); const f32x4 h = xv + acc[ai][bj][m][n];
                        s += (h[0] * h[0] + h[1] * h[1]) + (h[2] * h[2] + h[3] * h[3]); *(f32x4*)(out + off + bj * HALF + n * 16) = h; }
                s += __shfl_xor(s, 16); s += __shfl_xor(s, 32);
                if (fq == 0) atomicAdd(ssq + row, s); }
    }
};
template <class Epi, class Sched, bool ALIGN_EPI = false, bool SP2 = false>
__device__ __forceinline__ void gemm_phase(PG8_LAS unsigned char* lds, const Gemm g, const Sched& S, const Epi& E) {
    const int tid = threadIdx.x, wid = __builtin_amdgcn_readfirstlane(tid >> 6), lane = tid & 63, wr = wid >> 2, wc = wid & 3, fr = lane & 15, fq = lane >> 4;
    const int K = g.K, nt = K / BK;
    unsigned voffA[2], voffB[2];
#pragma unroll
    for (int i = 0; i < 2; ++i) { int R, C; stage_rc(tid * 16 + i * 8192, R, C); const int Rb = Epi::PERM ? ((R & ~31) + perm32(R & 31)) : R;
        voffA[i] = (unsigned)(R * K + C) * 2u; voffB[i] = (unsigned)(Rb * K + C) * 2u; }
    const size_t kstep = (size_t)(BK * 2);
    const size_t hstep = (size_t)HALF * K * 2;
    const size_t tstep = 2 * hstep;
    const unsigned ldsw = (unsigned)wid * 1024u;
    const int aoff = lds_byte(wr * 64 + fr, fq * 8), boff = lds_byte(wc * 32 + fr, fq * 8);
#define PG8_SA(b, h) (((b) * 2 + (h)) * HTB)
#define PG8_SB(b, h) ((4 + (b) * 2 + (h)) * HTB)
#define PG8_STAGE(bufoff, gbase, voff) do { _Pragma("unroll") for (int _i = 0; _i < 2; ++_i) \
        __builtin_amdgcn_global_load_lds((const unsigned*)((const char*)(gbase) + (voff)[_i]), (PG8_LAS unsigned*)(lds + (bufoff) + ldsw + _i * 8192), 16, 0, 0); } while (0)
#define PG8_LDA(dst, b, h) do { _Pragma("unroll") for (int m = 0; m < 4; ++m) _Pragma("unroll") for (int k = 0; k < 2; ++k) dst[m][k] = *(const PG8_LAS bf16x8*)(lds + PG8_SA(b, h) + aoff + m * 2048 + k * 1024); } while (0)
#define PG8_LDB(dst, b, h) do { _Pragma("unroll") for (int n = 0; n < 2; ++n) _Pragma("unroll") for (int k = 0; k < 2; ++k) dst[n][k] = *(const PG8_LAS bf16x8*)(lds + PG8_SB(b, h) + boff + n * 2048 + k * 1024); } while (0)
#define PG8_MMA(ai, bj, At, Bt) do { __builtin_amdgcn_s_setprio(1); _Pragma("unroll") for (int m = 0; m < 4; ++m) _Pragma("unroll") for (int n = 0; n < 2; ++n) _Pragma("unroll") for (int k = 0; k < 2; ++k) \
        acc[ai][bj][m][n] = __builtin_amdgcn_mfma_f32_16x16x32_bf16(Bt[n][k], At[m][k], acc[ai][bj][m][n], 0, 0, 0); __builtin_amdgcn_s_setprio(0); } while (0)
#define PG8_WAIT_V(n) asm volatile("s_waitcnt vmcnt(" #n ")" ::: "memory")
#define PG8_WAIT_L(n) asm volatile("s_waitcnt lgkmcnt(" #n ")" ::: "memory")
#define PG8_BAR __builtin_amdgcn_s_barrier()
#define PG8_SCHED __builtin_amdgcn_sched_barrier(0)
    Unit cur, nxt; int ui = 0;
    if (!S.next(0, cur)) return;
    f32x4 acc[2][2][4][2];
#pragma unroll
    for (int a = 0; a < 2; ++a)
#pragma unroll
        for (int b = 0; b < 2; ++b)
#pragma unroll
            for (int m = 0; m < 4; ++m)
#pragma unroll
                for (int n = 0; n < 2; ++n) acc[a][b][m][n] = (f32x4){0.f, 0.f, 0.f, 0.f};
    bf16x8 At[4][2], B0[2][2], B1[2][2];
    const char* cA = (const char*)g.A + (size_t)cur.pm * tstep; const char* cB = (const char*)g.Bt + (size_t)cur.pn * tstep;
    S.a_ready(cur);
    if constexpr (SP2) {
        PG8_STAGE(PG8_SB(0, 0), cB, voffB); PG8_STAGE(PG8_SB(0, 1), cB + hstep, voffB); PG8_STAGE(PG8_SA(0, 0), cA, voffA); PG8_STAGE(PG8_SA(0, 1), cA + hstep, voffA);
        if (wr == 1) PG8_BAR;
        PG8_WAIT_V(2); PG8_BAR;
        PG8_STAGE(PG8_SB(1, 0), cB + kstep, voffB); PG8_STAGE(PG8_SA(1, 0), cA + kstep, voffA); PG8_STAGE(PG8_SB(1, 1), cB + hstep + kstep, voffB);
        PG8_WAIT_V(6); PG8_BAR;
    } else {
        PG8_STAGE(PG8_SB(0, 0), cB, voffB); PG8_STAGE(PG8_SA(0, 0), cA, voffA); PG8_STAGE(PG8_SB(0, 1), cB + hstep, voffB); PG8_STAGE(PG8_SA(0, 1), cA + hstep, voffA);
        if (wr == 1) PG8_BAR;
        PG8_WAIT_V(4); PG8_BAR;
        PG8_STAGE(PG8_SB(1, 0), cB + kstep, voffB); PG8_STAGE(PG8_SA(1, 0), cA + kstep, voffA); PG8_STAGE(PG8_SB(1, 1), cB + hstep + kstep, voffB);
        PG8_WAIT_V(6); PG8_BAR;
    }
    for (;;) {
        const bool has_next = S.next(ui + 1, nxt);
        const char* nA = has_next ? (const char*)g.A + (size_t)nxt.pm * tstep : cA; const char* nB = has_next ? (const char*)g.Bt + (size_t)nxt.pn * tstep : cB;
        for (int t = 0; t < nt; t += 2) {
            if constexpr (Epi::HAS_MID) { if (t == Epi::MID_T) E.mid(acc, cur, wr, wc, fr, fq); }
            const bool last = (t == nt - 2);
            const char* a1 = cA + (size_t)(t + 1) * kstep;
            const char* a2 = last ? nA : cA + (size_t)(t + 2) * kstep; const char* b2 = last ? nB : cB + (size_t)(t + 2) * kstep;
            const char* a3 = a2 + kstep; const char* b3 = b2 + kstep;
            if (last && has_next) S.a_ready(nxt);
            if constexpr (SP2) {
            PG8_LDB(B0, 0, 0); PG8_LDB(B1, 0, 1); PG8_SCHED; PG8_LDA(At, 0, 0); PG8_STAGE(PG8_SA(1, 1), a1 + hstep, voffA);
            PG8_WAIT_V(8); PG8_WAIT_L(0); PG8_BAR; PG8_MMA(0, 0, At, B0); PG8_MMA(0, 1, At, B1); PG8_BAR; PG8_SCHED;
            PG8_LDA(At, 0, 1); PG8_STAGE(PG8_SB(0, 0), b2, voffB); PG8_STAGE(PG8_SB(0, 1), b2 + hstep, voffB); PG8_STAGE(PG8_SA(0, 0), a2, voffA);
            PG8_WAIT_V(8); PG8_WAIT_L(0); PG8_BAR; PG8_MMA(1, 0, At, B0); PG8_MMA(1, 1, At, B1); PG8_BAR; PG8_SCHED;
            PG8_LDB(B0, 1, 0); PG8_LDB(B1, 1, 1); PG8_SCHED; PG8_LDA(At, 1, 0); PG8_STAGE(PG8_SA(0, 1), a2 + hstep, voffA);
            PG8_WAIT_V(8); PG8_WAIT_L(0); PG8_BAR; PG8_MMA(0, 0, At, B0); PG8_MMA(0, 1, At, B1); PG8_BAR; PG8_SCHED;
            PG8_LDA(At, 1, 1); PG8_STAGE(PG8_SB(1, 0), b3, voffB); PG8_STAGE(PG8_SB(1, 1), b3 + hstep, voffB); PG8_STAGE(PG8_SA(1, 0), a3, voffA);
            PG8_WAIT_V(8); PG8_WAIT_L(0); PG8_BAR; PG8_MMA(1, 0, At, B0); PG8_MMA(1, 1, At, B1); PG8_BAR; PG8_SCHED;
            } else {
            PG8_LDB(B0, 0, 0); PG8_SCHED; PG8_LDA(At, 0, 0); PG8_STAGE(PG8_SA(1, 1), a1 + hstep, voffA);
            PG8_WAIT_L(8); PG8_BAR; PG8_WAIT_L(0); PG8_MMA(0, 0, At, B0); PG8_BAR; PG8_SCHED;
            PG8_LDB(B1, 0, 1); PG8_STAGE(PG8_SB(0, 0), b2, voffB);
            PG8_BAR; PG8_WAIT_L(0); PG8_MMA(0, 1, At, B1); PG8_BAR;
            PG8_LDA(At, 0, 1); PG8_STAGE(PG8_SA(0, 0), a2, voffA);
            PG8_BAR; PG8_WAIT_L(0); PG8_MMA(1, 0, At, B0); PG8_BAR; PG8_SCHED;
            PG8_STAGE(PG8_SB(0, 1), b2 + hstep, voffB);
            PG8_WAIT_V(6); PG8_BAR; PG8_MMA(1, 1, At, B1); PG8_BAR;
            PG8_LDB(B0, 1, 0); PG8_SCHED; PG8_LDA(At, 1, 0); PG8_STAGE(PG8_SA(0, 1), a2 + hstep, voffA);
            PG8_WAIT_L(8); PG8_BAR; PG8_WAIT_L(0); PG8_MMA(0, 0, At, B0); PG8_BAR; PG8_SCHED;
            PG8_LDB(B1, 1, 1); PG8_STAGE(PG8_SB(1, 0), b3, voffB);
            PG8_BAR; PG8_WAIT_L(0); PG8_MMA(0, 1, At, B1); PG8_BAR;
            PG8_LDA(At, 1, 1); PG8_STAGE(PG8_SA(1, 0), a3, voffA);
            PG8_BAR; PG8_WAIT_L(0); PG8_MMA(1, 0, At, B0); PG8_BAR; PG8_SCHED;
            PG8_STAGE(PG8_SB(1, 1), b3 + hstep, voffB);
            PG8_WAIT_V(6); PG8_BAR; PG8_MMA(1, 1, At, B1); PG8_BAR;
            }
        }
        if constexpr (ALIGN_EPI) { if (wr == 0) PG8_BAR; }
        if constexpr (!Epi::AFTER_DRAIN) { E(acc, cur, wr, wc, fr, fq); S.done(cur); }
        if (!has_next) break;
#pragma unroll
        for (int a = 0; a < 2; ++a)
#pragma unroll
            for (int b = 0; b < 2; ++b)
#pragma unroll
                for (int m = 0; m < 4; ++m)
#pragma unroll
                    for (int n = 0; n < 2; ++n) acc[a][b][m][n] = (f32x4){0.f, 0.f, 0.f, 0.f};
        cur = nxt; cA = nA; cB = nB; ++ui;
        if constexpr (ALIGN_EPI) { if (wr == 1) PG8_BAR; }
    }
    PG8_WAIT_V(0);
    if constexpr (!ALIGN_EPI) { if (wr == 0) PG8_BAR; }
    PG8_BAR;
    if constexpr (Epi::AFTER_DRAIN) { E.fused(acc, cur, wr, wc, fr, fq, lds, wid, lane); S.done(cur); }
#undef PG8_SA
#undef PG8_SB
#undef PG8_STAGE
#undef PG8_LDA
#undef PG8_LDB
#undef PG8_MMA
#undef PG8_WAIT_V
#undef PG8_WAIT_L
#undef PG8_BAR
#undef PG8_SCHED
}
}

namespace fa {
typedef unsigned short bf16;
typedef short bf16x8 __attribute__((ext_vector_type(8)));
typedef short s16x4 __attribute__((ext_vector_type(4)));
typedef float f32x16 __attribute__((ext_vector_type(16)));
typedef float f32x4 __attribute__((ext_vector_type(4)));
typedef unsigned u32x4 __attribute__((ext_vector_type(4)));
constexpr int D = 128, QP = 2048, KP = 1024, ZP = 1024, SEQ = 4096;
constexpr float SCALE = 0.08838834764831845f, INV_SCALE = 11.313708498984761f;
constexpr float THR = 8.f;
constexpr int NW = 8, QBLK = 32, KVBLK = 64, QB = NW * QBLK;
constexpr int SHM_V = KVBLK * D * 2, SHM_K = KVBLK * D * 2;
constexpr int LDS_WS_OFF = 2 * SHM_V + 2 * SHM_K;
constexpr int LDS_CB_OFF = LDS_WS_OFF + NW * 64 * 4;
constexpr int CB_BYTES = SEQ * 8;
constexpr int LDS_STG_OFF = LDS_CB_OFF + CB_BYTES;
constexpr int LDS_BYTES = LDS_STG_OFF + NW * 4352;

#define KSWZ(row, colB) ((row) * 256 + ((colB) ^ (((row) & 7) << 4)))
#define SBAR() __builtin_amdgcn_sched_barrier(0)
__device__ __forceinline__ int v_st(int k, int c) { const int kk = (k & ~0xC) | ((k & 4) << 1) | ((k & 8) >> 1); return ((kk >> 3) * 4 + (c >> 5)) * 512 + ((kk & 7) * 32 + (c & 31)) * 2; }
__device__ __forceinline__ int v_rd_base(int lane) { return ((lane & 3) << 3) | (((lane >> 2) & 3) << 6) | (((lane >> 4) & 1) << 5) | (((lane >> 5) & 1) << 8); }
constexpr int v_rd_off(int d0, int ks, int half) { return d0 * 512 + ks * 4096 + half * 2048; }
__device__ __forceinline__ int crow(int r, int hi) { return (r & 3) + 8 * (r >> 2) + 4 * hi; }
__device__ __forceinline__ unsigned cvtpk(float lo, float hi) { unsigned r; asm volatile("v_cvt_pk_bf16_f32 %0, %1, %2" : "=v"(r) : "v"(lo), "v"(hi)); return r; }
__device__ __forceinline__ bf16x8 load8(const bf16* p) { return *reinterpret_cast<const bf16x8*>(p); }
__device__ __forceinline__ void mask_tile(f32x16& p0, f32x16& p1, int dq, unsigned W) {
    const float NEG = -__builtin_inff();
#pragma unroll
    for (int r = 0; r < 16; ++r) {
        const int c = (r & 3) + 8 * (r >> 2);
        if ((unsigned)(dq - c) >= W) p0[r] = NEG;
        if ((unsigned)(dq - c - 32) >= W) p1[r] = NEG;
    }
}
__device__ __forceinline__ void partialSM(f32x16& p0, f32x16& p1, float& m_reg, float& mn, float& alpha) {
    float pmax = p0[0]; for (int r = 1; r < 16; ++r) pmax = fmaxf(pmax, p0[r]); for (int r = 0; r < 16; ++r) pmax = fmaxf(pmax, p1[r]);
    { auto rr = __builtin_amdgcn_permlane32_swap(__float_as_uint(pmax), __float_as_uint(pmax), false, false);
      pmax = fmaxf(__uint_as_float(rr[0]), __uint_as_float(rr[1])); }
    constexpr float C2 = 1.4426950408889634f * SCALE;
    if (__builtin_expect(__all((pmax - m_reg) * SCALE <= THR), 1)) { mn = m_reg; alpha = 1.f; }
    else { mn = fmaxf(m_reg, pmax); alpha = __builtin_amdgcn_exp2f((m_reg - mn) * C2); m_reg = mn; }
    const float mnL = -mn * C2;
    for (int r = 0; r < 16; ++r) p0[r] = fmaf(p0[r], C2, mnL); for (int r = 0; r < 16; ++r) p1[r] = fmaf(p1[r], C2, mnL);
    for (int r = 0; r < 16; ++r) p0[r] = __builtin_amdgcn_exp2f(p0[r]);
}
__device__ __forceinline__ void finishSM(f32x16& p0, f32x16& p1, float alpha, float& l_reg, bf16x8& pa0, bf16x8& pa1, bf16x8& pa2, bf16x8& pa3) {
    for (int r = 0; r < 16; ++r) p1[r] = __builtin_amdgcn_exp2f(p1[r]);
    float ps = 0; for (int r = 0; r < 16; ++r) ps += p0[r]; for (int r = 0; r < 16; ++r) ps += p1[r];
    { auto rr = __builtin_amdgcn_permlane32_swap(__float_as_uint(ps), __float_as_uint(ps), false, false);
      ps = __uint_as_float(rr[0]) + __uint_as_float(rr[1]); }
    l_reg = l_reg * alpha + ps;
#define PK4(P, B_, OUT) do { unsigned a0 = cvtpk(P[B_+0], P[B_+1]), a1 = cvtpk(P[B_+2], P[B_+3]);                          \
        unsigned b0 = cvtpk(P[B_+4], P[B_+5]), b1 = cvtpk(P[B_+6], P[B_+7]);                                             \
        auto r0 = __builtin_amdgcn_permlane32_swap(a0, b0, false, false); auto r1 = __builtin_amdgcn_permlane32_swap(a1, b1, false, false); \
        u32x4 w = {r0[0], r1[0], r0[1], r1[1]}; OUT = *reinterpret_cast<bf16x8*>(&w); } while (0)
    PK4(p0, 0, pa0); PK4(p0, 8, pa1); PK4(p1, 0, pa2); PK4(p1, 8, pa3);
#undef PK4
}
typedef unsigned u32x2 __attribute__((ext_vector_type(2)));
template <int KB>
__device__ __forceinline__ void qkt(f32x16& p0, f32x16& p1, const char* K_lds, const char* cbt, int r32, int hi, const bf16x8* qr) {
    { const u32x2 e0 = *(const u32x2*)(cbt), e1 = *(const u32x2*)(cbt + 32 * 8);
      const unsigned c0 = hi ? 0u : 0x3F803F80u, c1 = hi ? 0u : 0x00003F80u;
      const u32x4 k0 = {e0.x, e0.y, e0.x, e0.y}, k1 = {e1.x, e1.y, e1.x, e1.y}, q1 = {c0, c1, 0u, 0u};
      p0 = __builtin_amdgcn_mfma_f32_32x32x16_bf16(__builtin_bit_cast(bf16x8, k0), __builtin_bit_cast(bf16x8, q1), f32x16{}, 0, 0, 0);
      p1 = __builtin_amdgcn_mfma_f32_32x32x16_bf16(__builtin_bit_cast(bf16x8, k1), __builtin_bit_cast(bf16x8, q1), f32x16{}, 0, 0, 0); }
    const char* kb[4];
#pragma unroll
    for (int dd = 0; dd < 4; ++dd) kb[dd] = K_lds + KB * SHM_K + KSWZ(r32, (dd * 16 + hi * 8) * 2);
#pragma unroll
    for (int d0 = 0; d0 < 8; ++d0) { const char* a = kb[d0 & 3] + (d0 >> 2) * 128;
        bf16x8 b0 = *reinterpret_cast<const bf16x8*>(a);
        bf16x8 b1 = *reinterpret_cast<const bf16x8*>(a + 32 * 256);
        p0 = __builtin_amdgcn_mfma_f32_32x32x16_bf16(b0, qr[d0], p0, 0, 0, 0);
        p1 = __builtin_amdgcn_mfma_f32_32x32x16_bf16(b1, qr[d0], p1, 0, 0, 0); }
}
template <int VB>
__device__ __forceinline__ void pv_tile(f32x16* o, int vb0, bf16x8 pa0, bf16x8 pa1, bf16x8 pa2, bf16x8 pa3) {
#define TRRD(dst, off) asm volatile("ds_read_b64_tr_b16 %0, %1 offset:%2" : "=&v"(dst) : "v"(vb0), "i"(off) : "memory")
#define VF(l, h) (bf16x8){l[0], l[1], l[2], l[3], h[0], h[1], h[2], h[3]}
#define PV_R(d0, ks, PA, PB) do { s16x4 l0, h0, l1, h1, m0, n0, m1, n1;                                                                \
        constexpr int b_ = VB * SHM_V + v_rd_off(d0, ks, 0), c_ = VB * SHM_V + v_rd_off(d0 + 1, ks, 0);                               \
        TRRD(l0, b_); TRRD(h0, b_ + 2048); TRRD(m0, c_); TRRD(n0, c_ + 2048); TRRD(l1, b_ + 4096); TRRD(h1, b_ + 6144); TRRD(m1, c_ + 4096); TRRD(n1, c_ + 6144); \
        asm volatile("s_waitcnt lgkmcnt(0)" ::: "memory"); SBAR();                                                                   \
        o[d0]     = __builtin_amdgcn_mfma_f32_32x32x16_bf16(PA, VF(l0, h0), o[d0], 0, 0, 0);                                          \
        o[d0 + 1] = __builtin_amdgcn_mfma_f32_32x32x16_bf16(PA, VF(m0, n0), o[d0 + 1], 0, 0, 0);                                      \
        o[d0]     = __builtin_amdgcn_mfma_f32_32x32x16_bf16(PB, VF(l1, h1), o[d0], 0, 0, 0);                                          \
        o[d0 + 1] = __builtin_amdgcn_mfma_f32_32x32x16_bf16(PB, VF(m1, n1), o[d0 + 1], 0, 0, 0); } while (0)
    PV_R(0, 0, pa0, pa1); PV_R(0, 2, pa2, pa3); PV_R(2, 0, pa0, pa1); PV_R(2, 2, pa2, pa3);
#undef PV_R
#undef VF
#undef TRRD
}

struct BlockRef { const bf16* Q; const bf16* K; const bf16* V; bf16* O; const bf16* Z; const float* C; int P0; };
struct Seam { bf16x8 qr[8]; bf16x8 st_v0, st_v1, st_k0, st_k1; };
__device__ __forceinline__ void fill_cb(const float* C, int P0, char* cb) {
    const int n = P0 + QB; const float ref = C[P0];
    for (int i = threadIdx.x * 4; i < n; i += 2048) { const f32x4 c = *(const f32x4*)(C + i); u32x4 o0, o1;
#pragma unroll
        for (int j = 0; j < 4; ++j) { const float x = (ref - c[j]) * INV_SCALE; const unsigned u1 = __float_as_uint(x) & 0xffff0000u; const float r1 = x - __uint_as_float(u1);
            const unsigned u2 = __float_as_uint(r1) & 0xffff0000u; const float r2 = r1 - __uint_as_float(u2); const unsigned u3 = cvtpk(r2, 0.f) & 0xffffu;
            const unsigned w0 = (u1 >> 16) | u2, w1 = u3;
            if (j < 2) { o0[2 * j] = w0; o0[2 * j + 1] = w1; } else { o1[2 * (j - 2)] = w0; o1[2 * (j - 2) + 1] = w1; } }
        *(u32x4*)(cb + (size_t)i * 8) = o0; *(u32x4*)(cb + (size_t)i * 8 + 16) = o1; }
}
#define ROWK(p, k0, rr) ((p) + (size_t)((k0) + (rr)) * KP + sc)
#define VMW() asm volatile("s_waitcnt vmcnt(0)" ::: "memory")
#define VMWN(n) asm volatile("s_waitcnt vmcnt(%0)" :: "i"(n) : "memory")
#define SLOAD_H(Kp, Vp, k0) do { S.st_v0 = load8(ROWK(Vp, k0, sr)); S.st_v1 = load8(ROWK(Vp, k0, 32 + sr));              \
                         S.st_k0 = load8(ROWK(Kp, k0, sr)); S.st_k1 = load8(ROWK(Kp, k0, 32 + sr)); } while (0)
#define OPQ_TID() int t_ = threadIdx.x; asm volatile("" : "+v"(t_)); const int sr_ = t_ >> 4, sc_ = (t_ & 15) * 8
#define SWRITE_HK(bf) do { OPQ_TID(); const int kws_ = KSWZ(sr_, sc_ * 2); *(bf16x8*)(K_lds + (bf) * SHM_K + kws_) = S.st_k0; *(bf16x8*)(K_lds + (bf) * SHM_K + kws_ + 32 * 256) = S.st_k1; } while (0)
#define SWRITE_HV(bf) do { OPQ_TID(); const int vst0_ = v_st(sr_, sc_), vst1_ = v_st(32 + sr_, sc_); *(bf16x8*)(V_lds + (bf) * SHM_V + vst0_) = S.st_v0; *(bf16x8*)(V_lds + (bf) * SHM_V + vst1_) = S.st_v1; } while (0)
#define SWRITE_H(bf) do { SWRITE_HV(bf); SWRITE_HK(bf); } while (0)
__device__ __forceinline__ void fox_prime(const BlockRef& cur, char* lds, char* cbcur, Seam& S) {
    const int tid = threadIdx.x, wid = __builtin_amdgcn_readfirstlane(tid >> 6), lane = tid & 63, r32 = lane & 31, hi = lane >> 5;
    const int sr = tid >> 4, sc = (tid & 15) * 8; char* K_lds = lds + 2 * SHM_V;
    for (int d0 = 0; d0 < 8; ++d0) S.qr[d0] = load8(cur.Q + (size_t)(wid * QBLK + r32) * QP + d0 * 16 + hi * 8);
    SLOAD_H(cur.K, cur.V, cur.P0 + QB - KVBLK); VMW(); SWRITE_HK(0);
    fill_cb(cur.C, cur.P0, cbcur);
    __syncthreads();
}
__device__ __forceinline__ void fox_block(const BlockRef& cur, const BlockRef& nxt, char* lds, char* cbcur, char* cbnxt, Seam& S) {
    const int tid = threadIdx.x, wid = __builtin_amdgcn_readfirstlane(tid >> 6), lane = tid & 63, r32 = lane & 31, hi = lane >> 5;
    const int W = 1 << 30;
    const int NT = (cur.P0 + QB) / KVBLK;
    const int qlo = cur.P0 + wid * QBLK, qm = qlo + r32 - 4 * hi;
    char* V_lds = lds; char* K_lds = lds + 2 * SHM_V;
    float* ws = (float*)(lds + LDS_WS_OFF) + wid * 64; float* li_l = ws, * al_l = ws + 32;
    float m_reg = -1e30f, l_reg = 0; f32x16 o[4] = {};
    const int sr = tid >> 4, sc = (tid & 15) * 8;
    const int vb0 = (int)(uintptr_t)V_lds + v_rd_base(lane);
    const bf16* Kh = cur.K; const bf16* Vh = cur.V;
    const char* cbl = cbcur + 8 * r32;
#define RESC(a) do { if (__any((a) < 1.f)) { if (hi == 0) al_l[r32] = (a); asm volatile("s_waitcnt lgkmcnt(0)" ::: "memory");              \
                     for (int d_ = 0; d_ < 4; ++d_) for (int r = 0; r < 16; ++r) o[d_][r] *= al_l[crow(r, hi)]; } } while (0)
#define KBASE(t) ((NT - 1 - (t)) * KVBLK)
#define MASKT(P0_, P1_, t) do { const int kb_ = KBASE(t); if (kb_ + KVBLK - 1 > qlo) mask_tile(P0_, P1_, qm - kb_, (unsigned)W); } while (0)
    constexpr int NQL = 8;
#define SEAM_K0() do { VMWN(NQL); SWRITE_HK(0); SBAR(); } while (0)
    f32x16 pA0, pA1, pB0, pB1; float mnA, mnB, alA, alB; bf16x8 pa0, pa1, pa2, pa3;
    SWRITE_HV(0); SBAR();
    if (NT > 1) { SLOAD_H(Kh, Vh, KBASE(1)); }
    SBAR(); qkt<0>(pA0, pA1, K_lds, cbl + 8 * KBASE(0), r32, hi, S.qr);
    MASKT(pA0, pA1, 0); partialSM(pA0, pA1, m_reg, mnA, alA);
    if (NT > 1) { VMW(); SWRITE_H(1); }
    __syncthreads();
#define HALF_STEP(PX0, PX1, mnX, alX, PY0, PY1, alY, t, KB, VB, SB) do {                                                      \
        SBAR(); if ((t) + 1 < NT) { SLOAD_H(Kh, Vh, KBASE((t) + 1)); SBAR(); }     \
        qkt<KB>(PX0, PX1, K_lds, cbl + 8 * KBASE(t), r32, hi, S.qr);                                             \
        finishSM(PY0, PY1, alY, l_reg, pa0, pa1, pa2, pa3); SBAR();                                                           \
        pv_tile<VB>(o, vb0, pa0, pa1, pa2, pa3); MASKT(PX0, PX1, (t)); partialSM(PX0, PX1, m_reg, mnX, alX);                                        \
        __syncthreads();                                                                                                      \
        if ((t) + 1 < NT) { VMW(); SWRITE_H(SB); }                                                                          \
        RESC(alX); __syncthreads(); } while (0)
    for (int t = 1; t + 1 < NT; t += 2) {
        HALF_STEP(pB0, pB1, mnB, alB, pA0, pA1, alA, t, 1, 0, 0);
        HALF_STEP(pA0, pA1, mnA, alA, pB0, pB1, alB, t + 1, 0, 1, 1);
    }
    const bool even = (NT & 1) == 0;
    if (even) { SBAR(); qkt<1>(pB0, pB1, K_lds, cbl + 8 * KBASE(NT - 1), r32, hi, S.qr); SBAR(); }
    SLOAD_H(nxt.K, nxt.V, nxt.P0 + QB - KVBLK); SBAR();
#pragma unroll
    for (int d0 = 0; d0 < 8; ++d0) S.qr[d0] = load8(nxt.Q + (size_t)(wid * QBLK + r32) * QP + d0 * 16 + hi * 8);
    SBAR();
    finishSM(pA0, pA1, alA, l_reg, pa0, pa1, pa2, pa3); SBAR();
    pv_tile<0>(o, vb0, pa0, pa1, pa2, pa3);
    if (even) { MASKT(pB0, pB1, NT - 1); partialSM(pB0, pB1, m_reg, mnB, alB); __syncthreads(); RESC(alB);
        finishSM(pB0, pB1, alB, l_reg, pa0, pa1, pa2, pa3); SBAR(); pv_tile<1>(o, vb0, pa0, pa1, pa2, pa3); }
    SBAR(); SEAM_K0();
    if (hi == 0) li_l[r32] = l_reg; asm volatile("s_waitcnt lgkmcnt(0)" ::: "memory");
    float rli[16];
#pragma unroll
    for (int r = 0; r < 16; ++r) rli[r] = __builtin_amdgcn_rcpf(li_l[crow(r, hi)]);
    {
        int ln = lane; asm volatile("" : "+v"(ln)); const int r32e = ln & 31, hie = ln >> 5;
        char* stg = lds + LDS_STG_OFF + wid * 4352;
        bf16* Ow = cur.O + (size_t)(wid * QBLK) * QP; const bf16* Zw = cur.Z + (size_t)(wid * QBLK) * ZP;
#pragma unroll
        for (int half = 0; half < 2; ++half) {
#pragma unroll
            for (int rr = 0; rr < 8; ++rr) { const int r = half * 8 + rr; const int lrow = (rr & 3) + 8 * (rr >> 2) + 4 * hie;
#pragma unroll
                for (int d0 = 0; d0 < 4; ++d0) *(unsigned short*)(stg + lrow * 272 + (d0 * 32 + r32e) * 2) = (unsigned short)cvtpk(o[d0][r] * rli[r], 0.f); }
            asm volatile("s_waitcnt lgkmcnt(0)" ::: "memory");
#pragma unroll
            for (int it = 0; it < 4; ++it) { const int lrow = it * 4 + (ln >> 4), ch = ln & 15, grow = half * 16 + lrow;
                const u32x4 ov = *(const u32x4*)(stg + lrow * 272 + ch * 16); const u32x4 z = *(const u32x4*)(Zw + (size_t)grow * ZP + ch * 8);
                u32x4 w;
                w.x = cvtpk(__uint_as_float(ov.x << 16) * __uint_as_float(z.x << 16), __uint_as_float(ov.x & 0xffff0000u) * __uint_as_float(z.x & 0xffff0000u));
                w.y = cvtpk(__uint_as_float(ov.y << 16) * __uint_as_float(z.y << 16), __uint_as_float(ov.y & 0xffff0000u) * __uint_as_float(z.y & 0xffff0000u));
                w.z = cvtpk(__uint_as_float(ov.z << 16) * __uint_as_float(z.z << 16), __uint_as_float(ov.z & 0xffff0000u) * __uint_as_float(z.z & 0xffff0000u));
                w.w = cvtpk(__uint_as_float(ov.w << 16) * __uint_as_float(z.w << 16), __uint_as_float(ov.w & 0xffff0000u) * __uint_as_float(z.w & 0xffff0000u));
                *(u32x4*)(Ow + (size_t)grow * QP + ch * 8) = w; }
            asm volatile("s_waitcnt lgkmcnt(0)" ::: "memory");
        }
    }
    fill_cb(nxt.C, nxt.P0, cbnxt);
    __syncthreads();
#undef RESC
#undef KBASE
#undef MASKT
#undef SEAM_K0
#undef HALF_STEP
}
#undef ROWK
#undef VMW
#undef VMWN
#undef SLOAD_H
#undef SWRITE_HK
#undef SWRITE_HV
#undef SWRITE_H
#undef OPQ_TID
#undef KSWZ
#undef SBAR

struct Tensors { const bf16* AO; const bf16* K; const bf16* V; const bf16* ZB; const float* C; };
__device__ __forceinline__ BlockRef make_ref(const Tensors& T, int bh, int qb) {
    const int b = bh >> 3, h = bh & 7; const size_t row0 = (size_t)b * SEQ + (size_t)qb * QB;
    BlockRef r;
    r.Q = T.AO + row0 * QP + 1024 + h * D; r.O = (bf16*)r.Q;
    r.K = T.K + (size_t)b * SEQ * KP + h * D; r.V = T.V + (size_t)b * SEQ * KP + h * D;
    r.Z = T.ZB + row0 * ZP + h * D; r.C = T.C + (size_t)bh * SEQ; r.P0 = qb * QB;
    return r;
}
__device__ __forceinline__ void fox_phase(char* lds, const Tensors& T, int vcu, int G) {
    constexpr int total = 64 * 8;
    int L = vcu; if (L >= total) return;
    int pass = 0, par = 0;
    char* cb0 = lds + LDS_CB_OFF;
    BlockRef cur = make_ref(T, L >> 3, L & 7);
    Seam S;
    fox_prime(cur, lds, cb0, S);
    for (;;) {
        const bool more_pass = pass == 0, more_item = L + G < total, last = !more_pass && !more_item;
        int passn = pass + 1, Ln = L;
        if (!more_pass) { passn = 0; Ln = more_item ? L + G : L; }
        const int qbn = passn ? 15 - (Ln & 7) : (Ln & 7);
        const BlockRef nxt = last ? cur : make_ref(T, Ln >> 3, qbn);
        fox_block(cur, nxt, lds, cb0, cb0, S);
        if (last) break;
        cur = nxt; pass = passn; L = Ln; par ^= 1;
    }
}
}

#ifndef MK_N_LAUNCHES
#define MK_N_LAUNCHES 1
#endif
constexpr int N_LAUNCHES = MK_N_LAUNCHES;
constexpr int N_PHASES = 7;
constexpr int NWAVES = 8;
constexpr int BATCH = 8, SEQ = 4096, DM = 1024, T = BATCH * SEQ, NIN = 9224, NH = 8;
constexpr int NP1 = 7168, NG = 2048;
constexpr float EPS = 1e-6f;
constexpr size_t MiB = 1u << 20;
constexpr size_t WS_SSQ = 0, WS_LOGF = 1 * MiB, WS_CC = 2 * MiB, WS_WSM = 3 * MiB;
constexpr size_t WS_W1 = 4 * MiB, WS_WG = 18 * MiB, WS_WAB = 22 * MiB, WS_WO = 26 * MiB;
constexpr size_t WS_AO = 32 * MiB, WS_VA = 160 * MiB, WS_ZA = 224 * MiB, WS_K = 288 * MiB, WS_V = 352 * MiB, WS_ZB = 416 * MiB, WS_END = 480 * MiB;
constexpr int RING_BYTES = 131072, LDS_BYTES = 147456;
static_assert(fa::LDS_BYTES <= LDS_BYTES, "attention LDS");

#define GAS __attribute__((address_space(1)))
#define LAS __attribute__((address_space(3)))
typedef unsigned short bf16;
typedef unsigned v4u __attribute__((ext_vector_type(4)));
typedef float f32x4 __attribute__((ext_vector_type(4)));
typedef short bf16x8 __attribute__((ext_vector_type(8)));
#define LDS_WAIT() asm volatile("s_waitcnt lgkmcnt(0)" ::: "memory")
__device__ __forceinline__ unsigned f2bf(float f) { unsigned u = __builtin_bit_cast(unsigned, f); return (u + 0x7fffu + ((u >> 16) & 1u)) >> 16; }
__device__ __forceinline__ unsigned pk2(float lo, float hi) { return pg8::cvt_pk_bf16_c(lo, hi); }
__device__ __forceinline__ float wave_sum(float v) {
#pragma unroll
    for (int o = 1; o < 64; o <<= 1) v += __shfl_xor(v, o);
    return v;
}
__device__ __forceinline__ void transpose_item(const float* W, int ldw, int nblk, bf16* WT, int ldt, LAS float* scr, int item, int lane) {
    const int kb = item / nblk, nb = item % nblk, k0 = 64 * kb, n0 = 32 * nb;
#pragma unroll 8
    for (int i = 0; i < 32; ++i) { const int kk = 2 * i + (lane >> 5); scr[kk * 33 + (lane & 31)] = W[(size_t)(k0 + kk) * ldw + n0 + (lane & 31)]; }
    LDS_WAIT(); asm volatile("" ::: "memory");
    const int c = lane & 7;
#pragma unroll
    for (int j = 0; j < 4; ++j) { const int n = (lane >> 3) + 8 * j; const LAS float* s = scr + (8 * c) * 33 + n;
        v4u o; o.x = pk2(s[0 * 33], s[1 * 33]); o.y = pk2(s[2 * 33], s[3 * 33]); o.z = pk2(s[4 * 33], s[5 * 33]); o.w = pk2(s[6 * 33], s[7 * 33]);
        *(GAS v4u*)(WT + (size_t)(n0 + n) * ldt + k0 + 8 * c) = o; }
    LDS_WAIT(); asm volatile("" ::: "memory");
}

#define XB_TMO      128
#define XB_XCNT(j)  (256  + 64 * (j))
#define XB_XSUB(j)  (1280 + 64 * (j))
#define XB_XGEN(j)  (2304 + 64 * (j))
#define XB_TOP      3328
#define XB_TOPGEN   3392
#define XCD_BAR_WORDS 3456
#define XB_SPIN_CAP (1u << 18)

__device__ __forceinline__ unsigned xb_ld(unsigned* p)              { return __hip_atomic_load(p, __ATOMIC_RELAXED, __HIP_MEMORY_SCOPE_AGENT); }
__device__ __forceinline__ unsigned xb_add(unsigned* p, unsigned v) { return __hip_atomic_fetch_add(p, v, __ATOMIC_RELAXED, __HIP_MEMORY_SCOPE_AGENT); }
__device__ __forceinline__ unsigned xb_xcc_id() { return (unsigned)__builtin_amdgcn_s_getreg((3 << 11) | 20) & 0xFu; }
#define XB_SPIN(cond, bar) do { unsigned _sp = 0; while (cond) { __builtin_amdgcn_s_sleep(1); \
    if ((++_sp & 255u) == 0u) { if (xb_ld(&(bar)[XB_TMO])) break; if (_sp > XB_SPIN_CAP) { atomicAdd(&(bar)[XB_TMO], 1u); break; } } } } while (0)

struct XcdBarrier {
    unsigned* bar; unsigned x;
    volatile LAS unsigned* st;
};

__device__ __forceinline__ XcdBarrier xcd_barrier_post(unsigned* bar, volatile LAS unsigned* st) {
    XcdBarrier b; b.bar = bar; b.x = xb_xcc_id(); b.st = st;
    if (threadIdx.x == 0) (void)xb_add(&bar[XB_XCNT(b.x)], 1u);
    return b;
}
__device__ __forceinline__ void xcd_barrier_complete(unsigned* bar, unsigned x, unsigned& nloc, unsigned& nx) {
    const unsigned G = gridDim.x * gridDim.y * gridDim.z;
    unsigned sum, cnt, mine, sp = 0u;
    for (;;) {
        sum = 0u; cnt = 0u; mine = 0u;
#pragma unroll
        for (unsigned j = 0; j < 16; ++j) { const unsigned c = xb_ld(&bar[XB_XCNT(j)]); sum += c; cnt += (c > 0u) ? 1u : 0u; mine = (j == x) ? c : mine; }
        if (sum == G) break;
        __builtin_amdgcn_s_sleep(1);
        if ((++sp & 255u) == 0u) { if (xb_ld(&bar[XB_TMO])) break; if (sp > XB_SPIN_CAP) { atomicAdd(&bar[XB_TMO], 1u); break; } }
    }
    nloc = mine > 0u ? mine : 1u; nx = cnt > 0u ? cnt : 1u;
}

__device__ __forceinline__ void xcd_barrier(const XcdBarrier& b) {
    asm volatile("s_waitcnt vmcnt(0)" ::: "memory");
    __syncthreads();
    if (threadIdx.x == 0) {
        unsigned* bar = b.bar;
        __builtin_amdgcn_s_waitcnt(0);
        unsigned nloc = b.st[0], nx = b.st[1];
        if (nloc == 0u) { xcd_barrier_complete(bar, b.x, nloc, nx); b.st[0] = nloc; b.st[1] = nx; }
        const unsigned old = xb_add(&bar[XB_XSUB(b.x)], 1u);
        const unsigned gen = old / nloc;
        if (old + 1u == (gen + 1u) * nloc) {
            __builtin_amdgcn_fence(__ATOMIC_RELEASE, "agent");
            asm volatile("s_waitcnt vmcnt(0)" ::: "memory");
            const unsigned og = xb_add(&bar[XB_TOP], 1u);
            const unsigned tg = og / nx;
            if (og + 1u == (tg + 1u) * nx) xb_add(&bar[XB_TOPGEN], 1u);
            else XB_SPIN(xb_ld(&bar[XB_TOPGEN]) == tg, bar);
            __builtin_amdgcn_fence(__ATOMIC_ACQUIRE, "agent");
            xb_add(&bar[XB_XGEN(b.x)], 1u);
            asm volatile("s_waitcnt vmcnt(0)" ::: "memory");
        } else {
            XB_SPIN(xb_ld(&bar[XB_XGEN(b.x)]) == gen, bar);
            __builtin_amdgcn_fence(__ATOMIC_ACQUIRE, "agent");
            asm volatile("s_waitcnt vmcnt(0)" ::: "memory");
        }
    }
    __syncthreads();
}

constexpr size_t WS_BAR = 512 * 1024, WS_CNT = WS_BAR + 16384; constexpr int BAR_BYTES = 16384 + 128 * 256, MISC_OFF = 147200;
static_assert(XCD_BAR_WORDS * 4 <= 16384 && fa::LDS_BYTES <= MISC_OFF, "barrier words / LDS map");
struct Args { const float* in[13]; float* out; unsigned char* ws; int ph_lo, ph_hi; };

__device__ __forceinline__ void p0_prologue(const Args& a, LAS unsigned char* lds, int vcu, int G, int tid, int lane, int wave) {
    unsigned char* ws = a.ws;
    const float* x = a.in[0]; const float* n1g = a.in[1]; const float* w_in = a.in[2]; const float* w_sp = a.in[5]; const float* b_f = a.in[7];
    const float* wpa = a.in[9]; const float* wpb = a.in[10]; const float* wout = a.in[11];
    bf16* W1t = (bf16*)(ws + WS_W1); bf16* WGt = (bf16*)(ws + WS_WG); bf16* WABt = (bf16*)(ws + WS_WAB); bf16* WOt = (bf16*)(ws + WS_WO);
    bf16* WSM = (bf16*)(ws + WS_WSM); float* ssq = (float*)(ws + WS_SSQ); float* logf_ = (float*)(ws + WS_LOGF);
    bf16* XN = (bf16*)a.out;
    const int gw = vcu * NWAVES + wave, NGW = G * NWAVES, gt = vcu * 512 + tid, NGT = G * 512;
    LAS float* wf = (LAS float*)(lds + 73728);
    for (int i = tid; i < 8192; i += 512) { const int k = i >> 3, h = i & 7; wf[h * 1024 + k] = w_in[(size_t)k * NIN + 7168 + h]; }
    LAS float* scr = (LAS float*)(lds + wave * 8448);
    constexpr int I1 = 16 * (NP1 / 32), IG = 16 * (NG / 32), IS = 16 * 32;
    for (int it = gw; it < I1; it += NGW) transpose_item(w_in, NIN, NP1 / 32, W1t, 1024, scr, it, lane);
    (void)IG; (void)IS; (void)WGt; (void)WABt; (void)WOt; (void)wpa; (void)wpb; (void)wout;
    for (int i = gt; i < 8 * 128 * 128; i += NGT) { const int s = i & 127, t = (i >> 7) & 127; const float v = ((t >> 6) >= (s >> 6)) ? w_sp[i] : 0.f; WSM[i] = (bf16)f2bf(v); }
    for (int i = gt; i < T; i += NGT) ssq[i] = 0.f;
    __syncthreads();
    const GAS f32x4* gp = (const GAS f32x4*)n1g + lane;
    f32x4 gv[4];
#pragma unroll
    for (int j = 0; j < 4; ++j) gv[j] = gp[64 * j];
    f32x4 nv[4];
    if (gw < T) { const GAS f32x4* xr0 = (const GAS f32x4*)(x + (size_t)gw * DM) + lane;
#pragma unroll
        for (int j = 0; j < 4; ++j) nv[j] = xr0[64 * j]; }
    for (int m = gw; m < T; m += NGW) {
        f32x4 v[4]; float s2 = 0.f;
#pragma unroll
        for (int j = 0; j < 4; ++j) { v[j] = nv[j]; s2 += (v[j].x * v[j].x + v[j].y * v[j].y) + (v[j].z * v[j].z + v[j].w * v[j].w); }
        if (m + NGW < T) { const GAS f32x4* xr = (const GAS f32x4*)(x + (size_t)(m + NGW) * DM) + lane;
#pragma unroll
            for (int j = 0; j < 4; ++j) nv[j] = xr[64 * j]; }
        const float rstd = 1.0f / sqrtf(wave_sum(s2) * (1.f / DM) + EPS);
#pragma unroll
        for (int j = 0; j < 4; ++j) v[j] = v[j] * rstd * gv[j];
        GAS unsigned long long* o8 = (GAS unsigned long long*)(XN + (size_t)m * DM) + lane;
#pragma unroll
        for (int j = 0; j < 4; ++j) o8[64 * j] = (unsigned long long)pk2(v[j].x, v[j].y) | ((unsigned long long)pk2(v[j].z, v[j].w) << 32);
        float f[8];
#pragma unroll
        for (int h = 0; h < 8; ++h) { float acc = 0.f;
#pragma unroll
            for (int j = 0; j < 4; ++j) { const f32x4 w = *(const LAS f32x4*)(wf + h * 1024 + 256 * j + 4 * lane); acc += (v[j].x * w.x + v[j].y * w.y) + (v[j].z * w.z + v[j].w * w.w); }
            f[h] = wave_sum(acc); }
        float fz = f[0];
#pragma unroll
        for (int h = 1; h < 8; ++h) fz = (lane == h) ? f[h] : fz;
        if (lane < 8) { const float z = fz + b_f[lane]; const float ls = fminf(z, 0.f) - log1pf(expf(-fabsf(z)));
            const int b = m >> 12, s = m & 4095; logf_[((size_t)(b * NH + lane) << 12) + s] = ls; }
    }
}
__device__ __forceinline__ void cumsum_bh(const float* logf_, float* cc, int bh, LAS unsigned char* lds, int tid, int lane, int wave) {
    LAS float* wt = (LAS float*)lds;
    const float* src = logf_ + (size_t)bh * SEQ + tid * 8; float* dst = cc + (size_t)bh * SEQ + tid * 8;
    f32x4 a = *(const f32x4*)src, b = *(const f32x4*)(src + 4);
    a.y += a.x; a.z += a.y; a.w += a.z; b.x += a.w; b.y += b.x; b.z += b.y; b.w += b.z;
    float tot = b.w, inc = tot;
#pragma unroll
    for (int o = 1; o < 64; o <<= 1) { const float n = __shfl_up(inc, o); if (lane >= o) inc += n; }
    if (lane == 63) wt[wave] = inc;
    __syncthreads();
    float base = inc - tot;
    for (int w = 0; w < wave; ++w) base += wt[w];
    a = a + base; b = b + base;
    *(f32x4*)dst = a; *(f32x4*)(dst + 4) = b;
    __syncthreads();
}
constexpr int VN_PITCH = 260, YT_PITCH = 528, YT_OFF = 128 * VN_PITCH;
__device__ __forceinline__ void sgu_item(LAS unsigned char* lds, const bf16* VA, bf16* AO, const bf16* ZA, const bf16* WSM, const float* ln_g, const float* ln_b, const float* b_sp,
                                         int rb, int g, int tid, int lane, int wave, v4u (&vin)[4], int rbn, int gn, bool has_next) {
    const int r0 = rb * 128;
    v4u ureg[4], zreg[4];
    {
        const int row = tid >> 2, q = tid & 3;
        const v4u* up0 = (const v4u*)(AO + (size_t)(r0 + row) * 2048 + g * 128 + q * 32);
        const v4u* zp0 = (const v4u*)(ZA + (size_t)(r0 + row) * 1024 + g * 128 + q * 32);
#pragma unroll
        for (int i = 0; i < 4; ++i) { ureg[i] = up0[i]; zreg[i] = zp0[i]; }
    }
    {
        const int row = tid >> 2, q = tid & 3;
        float v[32];
#pragma unroll
        for (int i = 0; i < 4; ++i) { const v4u w = vin[i];
            v[8 * i + 0] = __uint_as_float(w.x << 16); v[8 * i + 1] = __uint_as_float(w.x & 0xffff0000u); v[8 * i + 2] = __uint_as_float(w.y << 16); v[8 * i + 3] = __uint_as_float(w.y & 0xffff0000u);
            v[8 * i + 4] = __uint_as_float(w.z << 16); v[8 * i + 5] = __uint_as_float(w.z & 0xffff0000u); v[8 * i + 6] = __uint_as_float(w.w << 16); v[8 * i + 7] = __uint_as_float(w.w & 0xffff0000u); }
        float s = 0.f;
#pragma unroll
        for (int i = 0; i < 32; ++i) s += v[i];
        s += __shfl_xor(s, 1); s += __shfl_xor(s, 2);
        const float mu = s * (1.f / 128.f); float s2 = 0.f;
#pragma unroll
        for (int i = 0; i < 32; ++i) { v[i] -= mu; s2 += v[i] * v[i]; }
        s2 += __shfl_xor(s2, 1); s2 += __shfl_xor(s2, 2);
        const float rstd = 1.0f / sqrtf(s2 * (1.f / 128.f) + EPS);
        const f32x4* gp = (const f32x4*)(ln_g + g * 128 + q * 32); const f32x4* bp = (const f32x4*)(ln_b + g * 128 + q * 32);
        LAS unsigned* dst = (LAS unsigned*)(lds + row * VN_PITCH + q * 64);
#pragma unroll
        for (int i = 0; i < 8; ++i) { const f32x4 gg = gp[i], bb = bp[i];
            dst[2 * i] = pk2(v[4 * i] * rstd * gg.x + bb.x, v[4 * i + 1] * rstd * gg.y + bb.y);
            dst[2 * i + 1] = pk2(v[4 * i + 2] * rstd * gg.z + bb.z, v[4 * i + 3] * rstd * gg.w + bb.w); }
    }
    __syncthreads();
    if (has_next) {
        const int row = tid >> 2, q = tid & 3;
        const v4u* vp = (const v4u*)(VA + (size_t)(rbn * 128 + row) * 1024 + gn * 128 + q * 32);
#pragma unroll
        for (int i = 0; i < 4; ++i) vin[i] = vp[i];
    }
    {
        const int fr = lane & 15, fq = lane >> 4, c = 16 * wave + fr;
        bf16x8 X[4];
#pragma unroll
        for (int kb = 0; kb < 4; ++kb) {
            const LAS unsigned short* p = (const LAS unsigned short*)(lds + (32 * kb + 8 * fq) * VN_PITCH + c * 2);
#pragma unroll
            for (int j = 0; j < 8; ++j) X[kb][j] = (short)p[j * (VN_PITCH / 2)];
        }
        const bf16* wg = WSM + (size_t)g * 16384 + fr * 128 + 8 * fq;
        f32x4 acc[8];
#pragma unroll
        for (int m = 0; m < 8; ++m) { acc[m] = (f32x4){0.f, 0.f, 0.f, 0.f};
#pragma unroll
            for (int kb = 0; kb < 4; ++kb) { if (m < 4 && kb >= 2) continue;
                const bf16x8 Y = *(const bf16x8*)(wg + m * 2048 + kb * 32);
                acc[m] = __builtin_amdgcn_mfma_f32_16x16x32_bf16(X[kb], Y, acc[m], 0, 0, 0); } }
#pragma unroll
        for (int m = 0; m < 8; ++m) { const int t = 16 * m + fr; const float bs = b_sp[g * 128 + t];
            *(LAS f32x4*)(lds + YT_OFF + t * YT_PITCH + (16 * wave + 4 * fq) * 4) = acc[m] + bs; }
    }
    __syncthreads();
    {
        const int row = tid >> 2, q = tid & 3;
        v4u* up = (v4u*)(AO + (size_t)(r0 + row) * 2048 + g * 128 + q * 32);
        const LAS f32x4* yp = (const LAS f32x4*)(lds + YT_OFF + row * YT_PITCH + q * 128);
#pragma unroll
        for (int i = 0; i < 4; ++i) { const v4u u = ureg[i], z = zreg[i]; const f32x4 y0 = yp[2 * i], y1 = yp[2 * i + 1];
            v4u o;
            o.x = pk2(__uint_as_float(u.x << 16) * y0.x * __uint_as_float(z.x << 16), __uint_as_float(u.x & 0xffff0000u) * y0.y * __uint_as_float(z.x & 0xffff0000u));
            o.y = pk2(__uint_as_float(u.y << 16) * y0.z * __uint_as_float(z.y << 16), __uint_as_float(u.y & 0xffff0000u) * y0.w * __uint_as_float(z.y & 0xffff0000u));
            o.z = pk2(__uint_as_float(u.z << 16) * y1.x * __uint_as_float(z.z << 16), __uint_as_float(u.z & 0xffff0000u) * y1.y * __uint_as_float(z.z & 0xffff0000u));
            o.w = pk2(__uint_as_float(u.w << 16) * y1.z * __uint_as_float(z.w << 16), __uint_as_float(u.w & 0xffff0000u) * y1.w * __uint_as_float(z.w & 0xffff0000u));
            up[i] = o; }
    }
}


__device__ __forceinline__ void late_transposes(const Args& a, LAS unsigned char* lds, int vcu, int G, int lane, int wave) {
    unsigned char* ws = a.ws; const float* w_in = a.in[2]; const float* wpa = a.in[9]; const float* wpb = a.in[10]; const float* wout = a.in[11];
    bf16* WGt = (bf16*)(ws + WS_WG); bf16* WABt = (bf16*)(ws + WS_WAB); bf16* WOt = (bf16*)(ws + WS_WO);
    LAS float* scr = (LAS float*)(lds + wave * 8448);
    constexpr int IG = 16 * (NG / 32), IS = 16 * 32;
    const int gw = vcu * NWAVES + wave, NGW = G * NWAVES;
    for (int it = gw; it < IG + 3 * IS; it += NGW) {
        int r = it;
        if (r < IG) { transpose_item(w_in + 7176, NIN, NG / 32, WGt, 1024, scr, r, lane); continue; } r -= IG;
        if (r < IS) { transpose_item(wpa, 1024, 32, WABt, 2048, scr, r, lane); continue; } r -= IS;
        if (r < IS) { transpose_item(wpb, 1024, 32, WABt + 1024, 2048, scr, r, lane); continue; } r -= IS;
        transpose_item(wout, 1024, 32, WOt, 1024, scr, r, lane);
    }
}

__global__ void __launch_bounds__(NWAVES * 64, 2) fwd_mega(Args args) {
    extern __shared__ __attribute__((aligned(16))) unsigned char lds_raw[];
    LAS unsigned char* lds = (LAS unsigned char*)lds_raw;
    __builtin_assume(__builtin_amdgcn_workitem_id_y() == 0); __builtin_assume(__builtin_amdgcn_workitem_id_z() == 0);
    const int wave = __builtin_amdgcn_readfirstlane(threadIdx.x >> 6);
#define PH_IDS() int tid = threadIdx.x; asm volatile("" : "+v"(tid)); const int lane = tid & 63
    const int G = gridDim.x; const int bx = blockIdx.x; const int vcu = (G % 8 == 0) ? (bx % 8) * (G / 8) + bx / 8 : bx;
    unsigned char* ws = args.ws;
    const int lo = args.ph_lo, hi = args.ph_hi;
#define IN(k) (lo <= (k) && (k) < hi)
#define SEAM(k) do { if (IN(k) && IN((k) + 1)) { if ((k) == 0) cg::this_grid().sync(); else xcd_barrier(xbar); } } while (0)
    { volatile LAS unsigned* m_ = (volatile LAS unsigned*)(lds + MISC_OFF); if (threadIdx.x < 16) m_[threadIdx.x] = 0u; }
    __syncthreads();
    if (lo == 0 && blockIdx.x == 0) { unsigned* bz = (unsigned*)(ws + WS_BAR); for (int i = threadIdx.x; i < BAR_BYTES / 4; i += NWAVES * 64) bz[i] = 0u; }
    XcdBarrier xbar; xbar.bar = (unsigned*)(ws + WS_BAR); xbar.x = 0; xbar.st = (volatile LAS unsigned*)(lds + MISC_OFF);
    bf16* XN = (bf16*)args.out;
    bf16* AO = (bf16*)(ws + WS_AO); bf16* VA = (bf16*)(ws + WS_VA); bf16* ZA = (bf16*)(ws + WS_ZA); bf16* KB = (bf16*)(ws + WS_K); bf16* VB = (bf16*)(ws + WS_V); bf16* ZB = (bf16*)(ws + WS_ZB);
    bf16* GA = VA; bf16* GB = ZA; bf16* MG = KB;
    float* ssq = (float*)(ws + WS_SSQ); float* logf_ = (float*)(ws + WS_LOGF); float* cc = (float*)(ws + WS_CC);

    if (IN(0)) { PH_IDS(); p0_prologue(args, lds, vcu, G, tid, lane, wave); __syncthreads(); }
    SEAM(0);
    xbar = xcd_barrier_post((unsigned*)(ws + WS_BAR), (volatile LAS unsigned*)(lds + MISC_OFF));
    if (IN(1)) {
        { PH_IDS(); for (int bh = vcu; bh < BATCH * NH; bh += G) cumsum_bh(logf_, cc, bh, lds, tid, lane, wave); }
        pg8::Gemm g{XN, (const bf16*)(ws + WS_W1), T, NP1, DM}; pg8::StaticOrder S; S.init(T, NP1, G, bx);
        pg8::EpiP1 E{AO, VA, ZA, KB, VB, ZB};
        pg8::gemm_phase<pg8::EpiP1, pg8::StaticOrder, true, true>(lds, g, S, E);
    }
    SEAM(1);
    if (IN(2)) {
        const bf16* WSM = (const bf16*)(ws + WS_WSM);
        const fa::Tensors FT{AO, KB, VB, ZB, cc};
        if (vcu & 1) { fa::fox_phase((char*)lds_raw, FT, vcu, G); __syncthreads(); { PH_IDS(); v4u vin[4];
                if (vcu < 2048) { const v4u* vp = (const v4u*)(VA + (size_t)((vcu >> 3) * 128 + (tid >> 2)) * 1024 + (vcu & 7) * 128 + (tid & 3) * 32);
#pragma unroll
                    for (int i = 0; i < 4; ++i) vin[i] = vp[i]; }
                for (int it = vcu; it < 2048; it += G) { const int itn = it + G; sgu_item(lds, VA, AO, ZA, WSM, args.in[3], args.in[4], args.in[6], it >> 3, it & 7, tid, lane, wave, vin, itn >> 3, itn & 7, itn < 2048); } __syncthreads(); late_transposes(args, lds, vcu, G, lane, wave); } }
        else { { PH_IDS(); v4u vin[4];
                if (vcu < 2048) { const v4u* vp = (const v4u*)(VA + (size_t)((vcu >> 3) * 128 + (tid >> 2)) * 1024 + (vcu & 7) * 128 + (tid & 3) * 32);
#pragma unroll
                    for (int i = 0; i < 4; ++i) vin[i] = vp[i]; }
                for (int it = vcu; it < 2048; it += G) { const int itn = it + G; sgu_item(lds, VA, AO, ZA, WSM, args.in[3], args.in[4], args.in[6], it >> 3, it & 7, tid, lane, wave, vin, itn >> 3, itn & 7, itn < 2048); } __syncthreads(); late_transposes(args, lds, vcu, G, lane, wave); } __syncthreads(); fa::fox_phase((char*)lds_raw, FT, vcu, G); }
    }
    SEAM(2);
    if (IN(3)) {
        pg8::Gemm g{XN, (const bf16*)(ws + WS_WG), T, NG, DM}; pg8::StaticOrder S; S.init(T, NG, G, bx);
        pg8::EpiGate E{GA, GB, args.in[8]};
        pg8::gemm_phase<pg8::EpiGate, pg8::StaticOrder, true, true>(lds, g, S, E);
    }
    if (G != 256) SEAM(3);
    if (IN(4)) {
        pg8::Gemm g{AO, (const bf16*)(ws + WS_WAB), T, DM, 2 * DM}; pg8::StaticOrder S; S.init(T, DM, G, bx);
        pg8::EpiMerged E{GA, GB, MG};
        pg8::gemm_phase<pg8::EpiMerged, pg8::StaticOrder, true, true>(lds, g, S, E);
    }
    SEAM(4);
    if (IN(5)) {
        pg8::Gemm g{MG, (const bf16*)(ws + WS_WO), T, DM, DM}; pg8::StaticOrder S; S.init(T, DM, G, bx);
        if (N_LAUNCHES == 1) { pg8::EpiOutNorm E{args.in[0], args.out, ssq, (unsigned*)(ws + WS_CNT), args.in[12], EPS};
            pg8::gemm_phase<pg8::EpiOutNorm, pg8::StaticOrder, true, true>(lds, g, S, E); }
        else { pg8::EpiOut E{args.in[0], args.out, ssq};
            pg8::gemm_phase<pg8::EpiOut, pg8::StaticOrder, true, true>(lds, g, S, E); }
    }
    if (N_LAUNCHES != 1) SEAM(5);
    if (IN(6) && N_LAUNCHES != 1) {
        PH_IDS(); const float* nfg = args.in[12];
        const int gw = vcu * NWAVES + wave, NGW = G * NWAVES;
        const GAS f32x4* gp = (const GAS f32x4*)nfg + lane;
        f32x4 gv[4];
#pragma unroll
        for (int j = 0; j < 4; ++j) gv[j] = gp[64 * j];
        for (int m = gw; m < T; m += NGW) {
            GAS f32x4* hr = (GAS f32x4*)(args.out + (size_t)m * DM) + lane;
            const float rstd = 1.0f / sqrtf(ssq[m] * (1.f / DM) + EPS);
#pragma unroll
            for (int j = 0; j < 4; ++j) { const f32x4 h = hr[64 * j]; hr[64 * j] = h * rstd * gv[j]; }
        }
    }
#undef IN
#undef SEAM
}


extern "C" void kernel_launch(void* const* d_in, const int* in_sizes, int n_in, void* d_out, int out_size, void* d_ws, size_t ws_size, hipStream_t stream) {
    static int grid = 0;
    if (grid == 0) {
        if (n_in != 13 || in_sizes[0] != T * DM || out_size != T * DM || ws_size < WS_END) { fprintf(stderr, "kernel_launch: shape/workspace mismatch (n_in %d, in0 %d, out %d, ws %zu)\n", n_in, n_in > 0 ? in_sizes[0] : -1, out_size, ws_size); grid = -1; return; }
        int dev = 0, cus = 0, per_cu = 0;
        if (hipGetDevice(&dev) != hipSuccess || hipDeviceGetAttribute(&cus, hipDeviceAttributeMultiprocessorCount, dev) != hipSuccess) { grid = -1; return; }
        if (hipFuncSetAttribute((const void*)fwd_mega, hipFuncAttributeMaxDynamicSharedMemorySize, LDS_BYTES) != hipSuccess) { fprintf(stderr, "kernel_launch: hipFuncSetAttribute failed\n"); grid = -1; return; }
        if (hipOccupancyMaxActiveBlocksPerMultiprocessor(&per_cu, (const void*)fwd_mega, NWAVES * 64, LDS_BYTES) != hipSuccess || per_cu < 1) { fprintf(stderr, "kernel_launch: occupancy query says %d\n", per_cu); per_cu = 1; }
        (void)hipGetLastError();
        grid = cus;
    }
    if (grid < 0) return;
    Args a{};
    for (int i = 0; i < 13; ++i) a.in[i] = (const float*)d_in[i];
    a.out = (float*)d_out; a.ws = (unsigned char*)d_ws;
    if (N_LAUNCHES == 1) {
        a.ph_lo = 0; a.ph_hi = N_PHASES;
        void* kargs[] = {&a};
        hipError_t e = hipLaunchCooperativeKernel((const void*)fwd_mega, dim3(grid), dim3(NWAVES * 64), kargs, LDS_BYTES, stream);
        if (e != hipSuccess) fprintf(stderr, "kernel_launch: cooperative launch failed: %s (grid %d)\n", hipGetErrorString(e), grid);
    } else {
        for (int p = 0; p < N_PHASES; ++p) { a.ph_lo = p; a.ph_hi = p + 1; hipLaunchKernelGGL(fwd_mega, dim3(grid), dim3(NWAVES * 64), LDS_BYTES, stream, a); }
    }
}
```

```cpp
#include <hip/hip_runtime.h>
#include <hip/hip_cooperative_groups.h>
#include <cstdio>
#include <cstdint>
#include <cmath>
namespace cg = cooperative_groups;
namespace pg8 {
#define PG8_LAS __attribute__((address_space(3)))
typedef unsigned short bf16_t;
typedef short bf16x8 __attribute__((ext_vector_type(8)));
typedef float f32x4 __attribute__((ext_vector_type(4)));
typedef unsigned u32x4 __attribute__((ext_vector_type(4)));
constexpr int BM = 256, BK = 64, HALF = 128, HTB = HALF * BK * 2  , STAGE_BYTES = 8 * HTB, NXCD = 8, WGM = 8;

__host__ __device__ __forceinline__ int lds_byte(int r, int c) { const int st = (r >> 4) * 2 + (c >> 5), rr = r & 15, cc = c & 31, ob = rr * 64 + cc * 2; return st * 1024 + (ob ^ (((ob >> 9) & 1) << 5)); }
__host__ __device__ __forceinline__ void stage_rc(int b, int& R, int& C) { const int st = b / 1024, sb = b % 1024, swz = sb ^ (((sb >> 9) & 1) << 5); R = (st >> 1) * 16 + swz / 64; C = (st & 1) * 32 + (swz % 64) / 2; }
__host__ __device__ __forceinline__ int perm32(int rho) { const int n = rho >> 4, i = rho & 15; return 8 * (i >> 2) + 4 * n + (i & 3); }

struct Unit { int pm, pn; };
struct Gemm { const bf16_t* A; const bf16_t* Bt; int M, N, K; };

struct StaticOrder {
    int nM, nN, nwg, G, c;
    __host__ __device__ void init(int M, int N, int G_, int c_) { nM = M / BM; nN = N / BM; nwg = nM * nN; G = G_; c = c_; }
    __host__ __device__ bool next(int i, Unit& u) const {
        const long L = (long)i * G + c; if (L >= nwg) return false;
        int wgid = (int)L; { const int q = nwg / NXCD, r = nwg % NXCD, xcd = wgid % NXCD, off = wgid / NXCD; wgid = (xcd < r ? xcd * (q + 1) : r * (q + 1) + (xcd - r) * q) + off; }
        const int nig = WGM * nN, gid = wgid / nig, fm = gid * WGM, gsz = (nM - fm) < WGM ? (nM - fm) : WGM;
        u.pm = fm + ((wgid % nig) % gsz); u.pn = (wgid % nig) / gsz; return true;
    }
    __device__ __forceinline__ void a_ready(const Unit&) const {}
    __device__ __forceinline__ void done(const Unit&) const {}
};

__device__ __forceinline__ unsigned cvt_pk_bf16(float lo, float hi) { unsigned r; asm volatile("v_cvt_pk_bf16_f32 %0, %1, %2" : "=v"(r) : "v"(lo), "v"(hi)); return r; }
typedef float f32x2 __attribute__((ext_vector_type(2)));

__device__ __forceinline__ float silu_f(float v) { return v * __builtin_amdgcn_rcpf(1.0f + __builtin_amdgcn_exp2f(-1.4426950408889634f * v)); }
__device__ __forceinline__ float sigm_f(float v) { return __builtin_amdgcn_rcpf(1.0f + __builtin_amdgcn_exp2f(-1.4426950408889634f * v)); }
typedef float f32x2c_t __attribute__((ext_vector_type(2))); typedef __bf16 bf16x2c_t __attribute__((ext_vector_type(2)));
__device__ __forceinline__ unsigned cvt_pk_bf16_c(float lo, float hi) { f32x2c_t v = {lo, hi}; bf16x2c_t b = __builtin_convertvector(v, bf16x2c_t); return __builtin_bit_cast(unsigned, b); }
__device__ __forceinline__ float bf_lo(unsigned w) { return __uint_as_float(w << 16); }
__device__ __forceinline__ float bf_hi(unsigned w) { return __uint_as_float(w & 0xffff0000u); }

struct EpiP1 {
    static constexpr bool PERM = true, AFTER_DRAIN = false, HAS_MID = false; static constexpr int MID_T = -1;
    bf16_t *AO, *VA, *ZA, *KB, *VB, *ZB;
    __device__ __forceinline__ void mid(f32x4 (&)[2][2][4][2], const Unit&, int, int, int, int) const {}
    __device__ __forceinline__ void operator()(const f32x4 (&acc)[2][2][4][2], const Unit& u, int wr, int wc, int fr, int fq) const {
        const int g = u.pn >> 2, cin = (u.pn & 3) * BM;
        bf16_t* base = g == 0 ? AO : g == 1 ? VA : g == 2 ? ZA : g == 3 ? AO + 1024 : g == 4 ? KB : g == 5 ? VB : ZB;
        const int ldc = (g == 0 || g == 3) ? 2048 : 1024;
        const bool act = (g == 2 || g == 6);
        const int row0 = u.pm * BM + wr * 64 + fr, col0 = cin + wc * 32 + 8 * fq;
#pragma unroll
        for (int ai = 0; ai < 2; ++ai)
#pragma unroll
            for (int m = 0; m < 4; ++m) { bf16_t* rowp = base + (size_t)(row0 + ai * HALF + m * 16) * ldc + col0;
#pragma unroll
                for (int bj = 0; bj < 2; ++bj) { f32x4 v0 = acc[ai][bj][m][0], v1 = acc[ai][bj][m][1];
                    if (act) {
#pragma unroll
                        for (int e = 0; e < 4; ++e) { v0[e] = silu_f(v0[e]); v1[e] = silu_f(v1[e]); } }
                    u32x4 w; w.x = cvt_pk_bf16(v0[0], v0[1]); w.y = cvt_pk_bf16(v0[2], v0[3]); w.z = cvt_pk_bf16(v1[0], v1[1]); w.w = cvt_pk_bf16(v1[2], v1[3]);
                    *(u32x4*)(rowp + bj * HALF) = w; } }
    }
};
struct EpiGate {
    static constexpr bool PERM = true, AFTER_DRAIN = false, HAS_MID = false; static constexpr int MID_T = -1;
    bf16_t *GA, *GB; const float* bias;
    __device__ __forceinline__ void mid(f32x4 (&)[2][2][4][2], const Unit&, int, int, int, int) const {}
    __device__ __forceinline__ void operator()(const f32x4 (&acc)[2][2][4][2], const Unit& u, int wr, int wc, int fr, int fq) const {
        const int g = u.pn >> 2, cin = (u.pn & 3) * BM;
        bf16_t* base = g == 0 ? GA : GB;
        const int row0 = u.pm * BM + wr * 64 + fr, col0 = cin + wc * 32 + 8 * fq, bcol0 = u.pn * BM + wc * 32 + 8 * fq;
        f32x4 bv[2][2];
#pragma unroll
        for (int bj = 0; bj < 2; ++bj)
#pragma unroll
            for (int n = 0; n < 2; ++n) bv[bj][n] = *(const f32x4*)(bias + bcol0 + bj * HALF + 4 * n);
#pragma unroll
        for (int ai = 0; ai < 2; ++ai)
#pragma unroll
            for (int m = 0; m < 4; ++m) { bf16_t* rowp = base + (size_t)(row0 + ai * HALF + m * 16) * 1024 + col0;
#pragma unroll
                for (int bj = 0; bj < 2; ++bj) { f32x4 v0 = acc[ai][bj][m][0] + bv[bj][0], v1 = acc[ai][bj][m][1] + bv[bj][1];
#pragma unroll
                    for (int e = 0; e < 4; ++e) { v0[e] = sigm_f(v0[e]); v1[e] = sigm_f(v1[e]); }
                    u32x4 w; w.x = cvt_pk_bf16_c(v0[0], v0[1]); w.y = cvt_pk_bf16_c(v0[2], v0[3]); w.z = cvt_pk_bf16_c(v1[0], v1[1]); w.w = cvt_pk_bf16_c(v1[2], v1[3]);
                    *(u32x4*)(rowp + bj * HALF) = w; } }
    }
};
struct EpiMerged {
    static constexpr bool PERM = true, AFTER_DRAIN = false, HAS_MID = true; static constexpr int MID_T = 16;
    const bf16_t *GA, *GB; bf16_t* MG;
    __device__ __forceinline__ void mid(f32x4 (&acc)[2][2][4][2], const Unit& u, int wr, int wc, int fr, int fq) const {
        asm volatile("" : "+v"(fr), "+v"(fq));
        const int row0 = u.pm * BM + wr * 64 + fr, col0 = u.pn * BM + wc * 32 + 8 * fq;
#pragma unroll
        for (int ai = 0; ai < 2; ++ai)
#pragma unroll
            for (int m = 0; m < 4; ++m) { const size_t off = (size_t)(row0 + ai * HALF + m * 16) * 1024 + col0;
#pragma unroll
                for (int bj = 0; bj < 2; ++bj) { const u32x4 a = *(const u32x4*)(GA + off + bj * HALF), b = *(const u32x4*)(GB + off + bj * HALF);
                    f32x4 r0, r1;
                    r0[0] = bf_lo(a.x) * __builtin_amdgcn_rcpf(bf_lo(b.x)); r0[1] = bf_hi(a.x) * __builtin_amdgcn_rcpf(bf_hi(b.x));
                    r0[2] = bf_lo(a.y) * __builtin_amdgcn_rcpf(bf_lo(b.y)); r0[3] = bf_hi(a.y) * __builtin_amdgcn_rcpf(bf_hi(b.y));
                    r1[0] = bf_lo(a.z) * __builtin_amdgcn_rcpf(bf_lo(b.z)); r1[1] = bf_hi(a.z) * __builtin_amdgcn_rcpf(bf_hi(b.z));
                    r1[2] = bf_lo(a.w) * __builtin_amdgcn_rcpf(bf_lo(b.w)); r1[3] = bf_hi(a.w) * __builtin_amdgcn_rcpf(bf_hi(b.w));
                    acc[ai][bj][m][0] *= r0; acc[ai][bj][m][1] *= r1; }
                if (m & 1) asm volatile("" ::: "memory"); }
    }
    __device__ __forceinline__ void operator()(const f32x4 (&acc)[2][2][4][2], const Unit& u, int wr, int wc, int fr, int fq) const {
        const int row0 = u.pm * BM + wr * 64 + fr, col0 = u.pn * BM + wc * 32 + 8 * fq;
#pragma unroll
        for (int ai = 0; ai < 2; ++ai)
#pragma unroll
            for (int m = 0; m < 4; ++m) { const size_t off = (size_t)(row0 + ai * HALF + m * 16) * 1024 + col0;
#pragma unroll
                for (int bj = 0; bj < 2; ++bj) { const u32x4 b = *(const u32x4*)(GB + off + bj * HALF);
                    const f32x4 v0 = acc[ai][bj][m][0], v1 = acc[ai][bj][m][1];
                    u32x4 w; w.x = cvt_pk_bf16(v0[0] * bf_lo(b.x), v0[1] * bf_hi(b.x)); w.y = cvt_pk_bf16(v0[2] * bf_lo(b.y), v0[3] * bf_hi(b.y));
                    w.z = cvt_pk_bf16(v1[0] * bf_lo(b.z), v1[1] * bf_hi(b.z)); w.w = cvt_pk_bf16(v1[2] * bf_lo(b.w), v1[3] * bf_hi(b.w));
                    *(u32x4*)(MG + off + bj * HALF) = w; } }
    }
};

struct EpiOutNorm {
    static constexpr bool PERM = false, AFTER_DRAIN = false, HAS_MID = false; static constexpr int MID_T = -1;
    const float* x; float* out; float* ssq; unsigned* cnt; const float* gw; float eps;
    __device__ __forceinline__ void mid(f32x4 (&)[2][2][4][2], const Unit&, int, int, int, int) const {}
    __device__ __forceinline__ void operator()(f32x4 (&acc)[2][2][4][2], const Unit& u, int wr, int wc, int fr, int fq) const {
        const int row0 = u.pm * BM + wr * 64 + fr, col0 = u.pn * BM + wc * 32 + 4 * fq;
#pragma unroll
        for (int ai = 0; ai < 2; ++ai)
#pragma unroll
            for (int m = 0; m < 4; ++m) { const int row = row0 + ai * HALF + m * 16; const size_t off = (size_t)row * 1024 + col0; float s = 0.f;
#pragma unroll
                for (int bj = 0; bj < 2; ++bj)
#pragma unroll
                    for (int n = 0; n < 2; ++n) { const f32x4 xv = *(const f32x4*)(x + off + bj * HALF + n * 16); const f32x4 h = xv + acc[ai][bj][m][n]; acc[ai][bj][m][n] = h;
                        s += (h[0] * h[0] + h[1] * h[1]) + (h[2] * h[2] + h[3] * h[3]); }
                s += __shfl_xor(s, 16); s += __shfl_xor(s, 32);
                if (fq == 0) __hip_atomic_fetch_add(ssq + row, s, __ATOMIC_RELAXED, __HIP_MEMORY_SCOPE_AGENT);
                asm volatile("" ::: "memory"); }
        asm volatile("s_waitcnt vmcnt(0)" ::: "memory");
        unsigned* c = cnt + 64 * u.pm;
        if ((threadIdx.x & 63) == 0) __hip_atomic_fetch_add(c, 1u, __ATOMIC_RELAXED, __HIP_MEMORY_SCOPE_AGENT);
        { unsigned sp = 0; while ((unsigned)__builtin_amdgcn_readfirstlane(__hip_atomic_load(c, __ATOMIC_RELAXED, __HIP_MEMORY_SCOPE_AGENT)) < 32u) { __builtin_amdgcn_s_sleep(2); if (++sp > (1u << 22)) break; } }
        asm volatile("" ::: "memory");
        f32x4 gv[2][2];
#pragma unroll
        for (int bj = 0; bj < 2; ++bj)
#pragma unroll
            for (int n = 0; n < 2; ++n) gv[bj][n] = *(const f32x4*)(gw + col0 + bj * HALF + n * 16);
#pragma unroll
        for (int ai = 0; ai < 2; ++ai)
#pragma unroll
            for (int m = 0; m < 4; ++m) { const int row = row0 + ai * HALF + m * 16; const size_t off = (size_t)row * 1024 + col0;
                const float ss = __hip_atomic_load(ssq + row, __ATOMIC_RELAXED, __HIP_MEMORY_SCOPE_AGENT);
                const float rstd = 1.0f / sqrtf(ss * (1.0f / 1024.0f) + eps);
#pragma unroll
                for (int bj = 0; bj < 2; ++bj)
#pragma unroll
                    for (int n = 0; n < 2; ++n) *(f32x4*)(out + off + bj * HALF + n * 16) = acc[ai][bj][m][n] * rstd * gv[bj][n]; }
    }
};
struct EpiOut {
    static constexpr bool PERM = false, AFTER_DRAIN = false, HAS_MID = false; static constexpr int MID_T = -1;
    const float* x; float* out; float* ssq;
    __device__ __forceinline__ void mid(f32x4 (&)[2][2][4][2], const Unit&, int, int, int, int) const {}
    __device__ __forceinline__ void operator()(const f32x4 (&acc)[2][2][4][2], const Unit& u, int wr, int wc, int fr, int fq) const {
        const int row0 = u.pm * BM + wr * 64 + fr, col0 = u.pn * BM + wc * 32 + 4 * fq;
#pragma unroll
        for (int ai = 0; ai < 2; ++ai)
#pragma unroll
            for (int m = 0; m < 4; ++m) { const int row = row0 + ai * HALF + m * 16; const size_t off = (size_t)row * 1024 + col0; float s = 0.f;
#pragma unroll
                for (int bj = 0; bj < 2; ++bj)
#pragma unroll
                    for (int n = 0; n < 2; ++n) { const f32x4 xv = *(const f32x4*)(x + off + bj * HALF + n * 16); const f32x4 h = xv + acc[ai][bj][m][n];
                        s += (h[0] * h[0] + h[1] * h[1]) + (h[2] * h[2] + h[3] * h[3]); *(f32x4*)(out + off + bj * HALF + n * 16) = h; }
                s += __shfl_xor(s, 16); s += __shfl_xor(s, 32);
                if (fq == 0) atomicAdd(ssq + row, s); }
    }
};
template <class Epi, class Sched, bool ALIGN_EPI = false, bool SP2 = false>
__device__ __forceinline__ void gemm_phase(PG8_LAS unsigned char* lds, const Gemm g, const Sched& S, const Epi& E) {
    const int tid = threadIdx.x, wid = __builtin_amdgcn_readfirstlane(tid >> 6), lane = tid & 63, wr = wid >> 2, wc = wid & 3, fr = lane & 15, fq = lane >> 4;
    const int K = g.K, nt = K / BK;
    unsigned voffA[2], voffB[2];
#pragma unroll
    for (int i = 0; i < 2; ++i) { int R, C; stage_rc(tid * 16 + i * 8192, R, C); const int Rb = Epi::PERM ? ((R & ~31) + perm32(R & 31)) : R;
        voffA[i] = (unsigned)(R * K + C) * 2u; voffB[i] = (unsigned)(Rb * K + C) * 2u; }
    const size_t kstep = (size_t)(BK * 2);
    const size_t hstep = (size_t)HALF * K * 2;
    const size_t tstep = 2 * hstep;
    const unsigned ldsw = (unsigned)wid * 1024u;
    const int aoff = lds_byte(wr * 64 + fr, fq * 8), boff = lds_byte(wc * 32 + fr, fq * 8);
#define PG8_SA(b, h) (((b) * 2 + (h)) * HTB)
#define PG8_SB(b, h) ((4 + (b) * 2 + (h)) * HTB)
#define PG8_STAGE(bufoff, gbase, voff) do { _Pragma("unroll") for (int _i = 0; _i < 2; ++_i) \
        __builtin_amdgcn_global_load_lds((const unsigned*)((const char*)(gbase) + (voff)[_i]), (PG8_LAS unsigned*)(lds + (bufoff) + ldsw + _i * 8192), 16, 0, 0); } while (0)
#define PG8_LDA(dst, b, h) do { _Pragma("unroll") for (int m = 0; m < 4; ++m) _Pragma("unroll") for (int k = 0; k < 2; ++k) dst[m][k] = *(const PG8_LAS bf16x8*)(lds + PG8_SA(b, h) + aoff + m * 2048 + k * 1024); } while (0)
#define PG8_LDB(dst, b, h) do { _Pragma("unroll") for (int n = 0; n < 2; ++n) _Pragma("unroll") for (int k = 0; k < 2; ++k) dst[n][k] = *(const PG8_LAS bf16x8*)(lds + PG8_SB(b, h) + boff + n * 2048 + k * 1024); } while (0)
#define PG8_MMA(ai, bj, At, Bt) do { __builtin_amdgcn_s_setprio(1); _Pragma("unroll") for (int m = 0; m < 4; ++m) _Pragma("unroll") for (int n = 0; n < 2; ++n) _Pragma("unroll") for (int k = 0; k < 2; ++k) \
        acc[ai][bj][m][n] = __builtin_amdgcn_mfma_f32_16x16x32_bf16(Bt[n][k], At[m][k], acc[ai][bj][m][n], 0, 0, 0); __builtin_amdgcn_s_setprio(0); } while (0)
#define PG8_WAIT_V(n) asm volatile("s_waitcnt vmcnt(" #n ")" ::: "memory")
#define PG8_WAIT_L(n) asm volatile("s_waitcnt lgkmcnt(" #n ")" ::: "memory")
#define PG8_BAR __builtin_amdgcn_s_barrier()
#define PG8_SCHED __builtin_amdgcn_sched_barrier(0)
    Unit cur, nxt; int ui = 0;
    if (!S.next(0, cur)) return;
    f32x4 acc[2][2][4][2];
#pragma unroll
    for (int a = 0; a < 2; ++a)
#pragma unroll
        for (int b = 0; b < 2; ++b)
#pragma unroll
            for (int m = 0; m < 4; ++m)
#pragma unroll
                for (int n = 0; n < 2; ++n) acc[a][b][m][n] = (f32x4){0.f, 0.f, 0.f, 0.f};
    bf16x8 At[4][2], B0[2][2], B1[2][2];
    const char* cA = (const char*)g.A + (size_t)cur.pm * tstep; const char* cB = (const char*)g.Bt + (size_t)cur.pn * tstep;
    S.a_ready(cur);
    if constexpr (SP2) {
        PG8_STAGE(PG8_SB(0, 0), cB, voffB); PG8_STAGE(PG8_SB(0, 1), cB + hstep, voffB); PG8_STAGE(PG8_SA(0, 0), cA, voffA); PG8_STAGE(PG8_SA(0, 1), cA + hstep, voffA);
        if (wr == 1) PG8_BAR;
        PG8_WAIT_V(2); PG8_BAR;
        PG8_STAGE(PG8_SB(1, 0), cB + kstep, voffB); PG8_STAGE(PG8_SA(1, 0), cA + kstep, voffA); PG8_STAGE(PG8_SB(1, 1), cB + hstep + kstep, voffB);
        PG8_WAIT_V(6); PG8_BAR;
    } else {
        PG8_STAGE(PG8_SB(0, 0), cB, voffB); PG8_STAGE(PG8_SA(0, 0), cA, voffA); PG8_STAGE(PG8_SB(0, 1), cB + hstep, voffB); PG8_STAGE(PG8_SA(0, 1), cA + hstep, voffA);
        if (wr == 1) PG8_BAR;
        PG8_WAIT_V(4); PG8_BAR;
        PG8_STAGE(PG8_SB(1, 0), cB + kstep, voffB); PG8_STAGE(PG8_SA(1, 0), cA + kstep, voffA); PG8_STAGE(PG8_SB(1, 1), cB + hstep + kstep, voffB);
        PG8_WAIT_V(6); PG8_BAR;
    }
    for (;;) {
        const bool has_next = S.next(ui + 1, nxt);
        const char* nA = has_next ? (const char*)g.A + (size_t)nxt.pm * tstep : cA; const char* nB = has_next ? (const char*)g.Bt + (size_t)nxt.pn * tstep : cB;
        for (int t = 0; t < nt; t += 2) {
            if constexpr (Epi::HAS_MID) { if (t == Epi::MID_T) E.mid(acc, cur, wr, wc, fr, fq); }
            const bool last = (t == nt - 2);
            const char* a1 = cA + (size_t)(t + 1) * kstep;
            const char* a2 = last ? nA : cA + (size_t)(t + 2) * kstep; const char* b2 = last ? nB : cB + (size_t)(t + 2) * kstep;
            const char* a3 = a2 + kstep; const char* b3 = b2 + kstep;
            if (last && has_next) S.a_ready(nxt);
            if constexpr (SP2) {
            PG8_LDB(B0, 0, 0); PG8_LDB(B1, 0, 1); PG8_SCHED; PG8_LDA(At, 0, 0); PG8_STAGE(PG8_SA(1, 1), a1 + hstep, voffA);
            PG8_WAIT_V(8); PG8_WAIT_L(0); PG8_BAR; PG8_MMA(0, 0, At, B0); PG8_MMA(0, 1, At, B1); PG8_BAR; PG8_SCHED;
            PG8_LDA(At, 0, 1); PG8_STAGE(PG8_SB(0, 0), b2, voffB); PG8_STAGE(PG8_SB(0, 1), b2 + hstep, voffB); PG8_STAGE(PG8_SA(0, 0), a2, voffA);
            PG8_WAIT_V(8); PG8_WAIT_L(0); PG8_BAR; PG8_MMA(1, 0, At, B0); PG8_MMA(1, 1, At, B1); PG8_BAR; PG8_SCHED;
            PG8_LDB(B0, 1, 0); PG8_LDB(B1, 1, 1); PG8_SCHED; PG8_LDA(At, 1, 0); PG8_STAGE(PG8_SA(0, 1), a2 + hstep, voffA);
            PG8_WAIT_V(8); PG8_WAIT_L(0); PG8_BAR; PG8_MMA(0, 0, At, B0); PG8_MMA(0, 1, At, B1); PG8_BAR; PG8_SCHED;
            PG8_LDA(At, 1, 1); PG8_STAGE(PG8_SB(1, 0), b3, voffB); PG8_STAGE(PG8_SB(1, 1), b3 + hstep, voffB); PG8_STAGE(PG8_SA(1, 0), a3, voffA);
            PG8_WAIT_V(8); PG8_WAIT_L(0); PG8_BAR; PG8_MMA(1, 0, At, B0); PG8_MMA(1, 1, At, B1); PG8_BAR; PG8_SCHED;
            } else {
            PG8_LDB(B0, 0, 0); PG8_SCHED; PG8_LDA(At, 0, 0); PG8_STAGE(PG8_SA(1, 1), a1 + hstep, voffA);
            PG8_WAIT_L(8); PG8_BAR; PG8_WAIT_L(0); PG8_MMA(0, 0, At, B0); PG8_BAR; PG8_SCHED;
            PG8_LDB(B1, 0, 1); PG8_STAGE(PG8_SB(0, 0), b2, voffB);
            PG8_BAR; PG8_WAIT_L(0); PG8_MMA(0, 1, At, B1); PG8_BAR;
            PG8_LDA(At, 0, 1); PG8_STAGE(PG8_SA(0, 0), a2, voffA);
            PG8_BAR; PG8_WAIT_L(0); PG8_MMA(1, 0, At, B0); PG8_BAR; PG8_SCHED;
            PG8_STAGE(PG8_SB(0, 1), b2 + hstep, voffB);
            PG8_WAIT_V(6); PG8_BAR; PG8_MMA(1, 1, At, B1); PG8_BAR;
            PG8_LDB(B0, 1, 0); PG8_SCHED; PG8_LDA(At, 1, 0); PG8_STAGE(PG8_SA(0, 1), a2 + hstep, voffA);
            PG8_WAIT_L(8); PG8_BAR; PG8_WAIT_L(0); PG8_MMA(0, 0, At, B0); PG8_BAR; PG8_SCHED;
            PG8_LDB(B1, 1, 1); PG8_STAGE(PG8_SB(1, 0), b3, voffB);
            PG8_BAR; PG8_WAIT_L(0); PG8_MMA(0, 1, At, B1); PG8_BAR;
            PG8_LDA(At, 1, 1); PG8_STAGE(PG8_SA(1, 0), a3, voffA);
            PG8_BAR; PG8_WAIT_L(0); PG8_MMA(1, 0, At, B0); PG8_BAR; PG8_SCHED;
            PG8_STAGE(PG8_SB(1, 1), b3 + hstep, voffB);
            PG8_WAIT_V(6); PG8_BAR; PG8_MMA(1, 1, At, B1); PG8_BAR;
            }
        }
        if constexpr (ALIGN_EPI) { if (wr == 0) PG8_BAR; }
        if constexpr (!Epi::AFTER_DRAIN) { E(acc, cur, wr, wc, fr, fq); S.done(cur); }
        if (!has_next) break;
#pragma unroll
        for (int a = 0; a < 2; ++a)
#pragma unroll
            for (int b = 0; b < 2; ++b)
#pragma unroll
                for (int m = 0; m < 4; ++m)
#pragma unroll
                    for (int n = 0; n < 2; ++n) acc[a][b][m][n] = (f32x4){0.f, 0.f, 0.f, 0.f};
        cur = nxt; cA = nA; cB = nB; ++ui;
        if constexpr (ALIGN_EPI) { if (wr == 1) PG8_BAR; }
    }
    PG8_WAIT_V(0);
    if constexpr (!ALIGN_EPI) { if (wr == 0) PG8_BAR; }
    PG8_BAR;
    if constexpr (Epi::AFTER_DRAIN) { E.fused(acc, cur, wr, wc, fr, fq, lds, wid, lane); S.done(cur); }
#undef PG8_SA
#undef PG8_SB
#undef PG8_STAGE
#undef PG8_LDA
#undef PG8_LDB
#undef PG8_MMA
#undef PG8_WAIT_V
#undef PG8_WAIT_L
#undef PG8_BAR
#undef PG8_SCHED
}
}

namespace fa {
typedef unsigned short bf16;
typedef short bf16x8 __attribute__((ext_vector_type(8)));
typedef short s16x4 __attribute__((ext_vector_type(4)));
typedef float f32x16 __attribute__((ext_vector_type(16)));
typedef float f32x4 __attribute__((ext_vector_type(4)));
typedef unsigned u32x4 __attribute__((ext_vector_type(4)));
constexpr int D = 128, QP = 2048, KP = 1024, ZP = 1024, SEQ = 4096;
constexpr float SCALE = 0.08838834764831845f, INV_SCALE = 11.313708498984761f;
constexpr float THR = 8.f;
constexpr int NW = 8, QBLK = 32, KVBLK = 64, QB = NW * QBLK;
constexpr int SHM_V = KVBLK * D * 2, SHM_K = KVBLK * D * 2;
constexpr int LDS_WS_OFF = 2 * SHM_V + 2 * SHM_K;
constexpr int LDS_CB_OFF = LDS_WS_OFF + NW * 64 * 4;
constexpr int CB_BYTES = SEQ * 8;
constexpr int LDS_STG_OFF = LDS_CB_OFF + CB_BYTES;
constexpr int LDS_BYTES = LDS_STG_OFF + NW * 4352;

#define KSWZ(row, colB) ((row) * 256 + ((colB) ^ (((row) & 7) << 4)))
#define SBAR() __builtin_amdgcn_sched_barrier(0)
__device__ __forceinline__ int v_st(int k, int c) { const int kk = (k & ~0xC) | ((k & 4) << 1) | ((k & 8) >> 1); return ((kk >> 3) * 4 + (c >> 5)) * 512 + ((kk & 7) * 32 + (c & 31)) * 2; }
__device__ __forceinline__ int v_rd_base(int lane) { return ((lane & 3) << 3) | (((lane >> 2) & 3) << 6) | (((lane >> 4) & 1) << 5) | (((lane >> 5) & 1) << 8); }
constexpr int v_rd_off(int d0, int ks, int half) { return d0 * 512 + ks * 4096 + half * 2048; }
__device__ __forceinline__ int crow(int r, int hi) { return (r & 3) + 8 * (r >> 2) + 4 * hi; }
__device__ __forceinline__ unsigned cvtpk(float lo, float hi) { unsigned r; asm volatile("v_cvt_pk_bf16_f32 %0, %1, %2" : "=v"(r) : "v"(lo), "v"(hi)); return r; }
__device__ __forceinline__ bf16x8 load8(const bf16* p) { return *reinterpret_cast<const bf16x8*>(p); }
__device__ __forceinline__ void mask_tile(f32x16& p0, f32x16& p1, int dq, unsigned W) {
    const float NEG = -__builtin_inff();
#pragma unroll
    for (int r = 0; r < 16; ++r) {
        const int c = (r & 3) + 8 * (r >> 2);
        if ((unsigned)(dq - c) >= W) p0[r] = NEG;
        if ((unsigned)(dq - c - 32) >= W) p1[r] = NEG;
    }
}
__device__ __forceinline__ void partialSM(f32x16& p0, f32x16& p1, float& m_reg, float& mn, float& alpha) {
    float pmax = p0[0]; for (int r = 1; r < 16; ++r) pmax = fmaxf(pmax, p0[r]); for (int r = 0; r < 16; ++r) pmax = fmaxf(pmax, p1[r]);
    { auto rr = __builtin_amdgcn_permlane32_swap(__float_as_uint(pmax), __float_as_uint(pmax), false, false);
      pmax = fmaxf(__uint_as_float(rr[0]), __uint_as_float(rr[1])); }
    constexpr float C2 = 1.4426950408889634f * SCALE;
    if (__builtin_expect(__all((pmax - m_reg) * SCALE <= THR), 1)) { mn = m_reg; alpha = 1.f; }
    else { mn = fmaxf(m_reg, pmax); alpha = __builtin_amdgcn_exp2f((m_reg - mn) * C2); m_reg = mn; }
    const float mnL = -mn * C2;
    for (int r = 0; r < 16; ++r) p0[r] = fmaf(p0[r], C2, mnL); for (int r = 0; r < 16; ++r) p1[r] = fmaf(p1[r], C2, mnL);
    for (int r = 0; r < 16; ++r) p0[r] = __builtin_amdgcn_exp2f(p0[r]);
}
__device__ __forceinline__ void finishSM(f32x16& p0, f32x16& p1, float alpha, float& l_reg, bf16x8& pa0, bf16x8& pa1, bf16x8& pa2, bf16x8& pa3) {
    for (int r = 0; r < 16; ++r) p1[r] = __builtin_amdgcn_exp2f(p1[r]);
    float ps = 0; for (int r = 0; r < 16; ++r) ps += p0[r]; for (int r = 0; r < 16; ++r) ps += p1[r];
    { auto rr = __builtin_amdgcn_permlane32_swap(__float_as_uint(ps), __float_as_uint(ps), false, false);
      ps = __uint_as_float(rr[0]) + __uint_as_float(rr[1]); }
    l_reg = l_reg * alpha + ps;
#define PK4(P, B_, OUT) do { unsigned a0 = cvtpk(P[B_+0], P[B_+1]), a1 = cvtpk(P[B_+2], P[B_+3]);                          \
        unsigned b0 = cvtpk(P[B_+4], P[B_+5]), b1 = cvtpk(P[B_+6], P[B_+7]);                                             \
        auto r0 = __builtin_amdgcn_permlane32_swap(a0, b0, false, false); auto r1 = __builtin_amdgcn_permlane32_swap(a1, b1, false, false); \
        u32x4 w = {r0[0], r1[0], r0[1], r1[1]}; OUT = *reinterpret_cast<bf16x8*>(&w); } while (0)
    PK4(p0, 0, pa0); PK4(p0, 8, pa1); PK4(p1, 0, pa2); PK4(p1, 8, pa3);
#undef PK4
}
typedef unsigned u32x2 __attribute__((ext_vector_type(2)));
template <int KB>
__device__ __forceinline__ void qkt(f32x16& p0, f32x16& p1, const char* K_lds, const char* cbt, int r32, int hi, const bf16x8* qr) {
    { const u32x2 e0 = *(const u32x2*)(cbt), e1 = *(const u32x2*)(cbt + 32 * 8);
      const unsigned c0 = hi ? 0u : 0x3F803F80u, c1 = hi ? 0u : 0x00003F80u;
      const u32x4 k0 = {e0.x, e0.y, e0.x, e0.y}, k1 = {e1.x, e1.y, e1.x, e1.y}, q1 = {c0, c1, 0u, 0u};
      p0 = __builtin_amdgcn_mfma_f32_32x32x16_bf16(__builtin_bit_cast(bf16x8, k0), __builtin_bit_cast(bf16x8, q1), f32x16{}, 0, 0, 0);
      p1 = __builtin_amdgcn_mfma_f32_32x32x16_bf16(__builtin_bit_cast(bf16x8, k1), __builtin_bit_cast(bf16x8, q1), f32x16{}, 0, 0, 0); }
    const char* kb[4];
#pragma unroll
    for (int dd = 0; dd < 4; ++dd) kb[dd] = K_lds + KB * SHM_K + KSWZ(r32, (dd * 16 + hi * 8) * 2);
#pragma unroll
    for (int d0 = 0; d0 < 8; ++d0) { const char* a = kb[d0 & 3] + (d0 >> 2) * 128;
        bf16x8 b0 = *reinterpret_cast<const bf16x8*>(a);
        bf16x8 b1 = *reinterpret_cast<const bf16x8*>(a + 32 * 256);
        p0 = __builtin_amdgcn_mfma_f32_32x32x16_bf16(b0, qr[d0], p0, 0, 0, 0);
        p1 = __builtin_amdgcn_mfma_f32_32x32x16_bf16(b1, qr[d0], p1, 0, 0, 0); }
}
template <int VB>
__device__ __forceinline__ void pv_tile(f32x16* o, int vb0, bf16x8 pa0, bf16x8 pa1, bf16x8 pa2, bf16x8 pa3) {
#define TRRD(dst, off) asm volatile("ds_read_b64_tr_b16 %0, %1 offset:%2" : "=&v"(dst) : "v"(vb0), "i"(off) : "memory")
#define VF(l, h) (bf16x8){l[0], l[1], l[2], l[3], h[0], h[1], h[2], h[3]}
#define PV_R(d0, ks, PA, PB) do { s16x4 l0, h0, l1, h1, m0, n0, m1, n1;                                                                \
        constexpr int b_ = VB * SHM_V + v_rd_off(d0, ks, 0), c_ = VB * SHM_V + v_rd_off(d0 + 1, ks, 0);                               \
        TRRD(l0, b_); TRRD(h0, b_ + 2048); TRRD(m0, c_); TRRD(n0, c_ + 2048); TRRD(l1, b_ + 4096); TRRD(h1, b_ + 6144); TRRD(m1, c_ + 4096); TRRD(n1, c_ + 6144); \
        asm volatile("s_waitcnt lgkmcnt(0)" ::: "memory"); SBAR();                                                                   \
        o[d0]     = __builtin_amdgcn_mfma_f32_32x32x16_bf16(PA, VF(l0, h0), o[d0], 0, 0, 0);                                          \
        o[d0 + 1] = __builtin_amdgcn_mfma_f32_32x32x16_bf16(PA, VF(m0, n0), o[d0 + 1], 0, 0, 0);                                      \
        o[d0]     = __builtin_amdgcn_mfma_f32_32x32x16_bf16(PB, VF(l1, h1), o[d0], 0, 0, 0);                                          \
        o[d0 + 1] = __builtin_amdgcn_mfma_f32_32x32x16_bf16(PB, VF(m1, n1), o[d0 + 1], 0, 0, 0); } while (0)
    PV_R(0, 0, pa0, pa1); PV_R(0, 2, pa2, pa3); PV_R(2, 0, pa0, pa1); PV_R(2, 2, pa2, pa3);
#undef PV_R
#undef VF
#undef TRRD
}

struct BlockRef { const bf16* Q; const bf16* K; const bf16* V; bf16* O; const bf16* Z; const float* C; int P0; };
struct Seam { bf16x8 qr[8]; bf16x8 st_v0, st_v1, st_k0, st_k1; };
__device__ __forceinline__ void fill_cb(const float* C, int P0, char* cb) {
    const int n = P0 + QB; const float ref = C[P0];
    for (int i = threadIdx.x * 4; i < n; i += 2048) { const f32x4 c = *(const f32x4*)(C + i); u32x4 o0, o1;
#pragma unroll
        for (int j = 0; j < 4; ++j) { const float x = (ref - c[j]) * INV_SCALE; const unsigned u1 = __float_as_uint(x) & 0xffff0000u; const float r1 = x - __uint_as_float(u1);
            const unsigned u2 = __float_as_uint(r1) & 0xffff0000u; const float r2 = r1 - __uint_as_float(u2); const unsigned u3 = cvtpk(r2, 0.f) & 0xffffu;
            const unsigned w0 = (u1 >> 16) | u2, w1 = u3;
            if (j < 2) { o0[2 * j] = w0; o0[2 * j + 1] = w1; } else { o1[2 * (j - 2)] = w0; o1[2 * (j - 2) + 1] = w1; } }
        *(u32x4*)(cb + (size_t)i * 8) = o0; *(u32x4*)(cb + (size_t)i * 8 + 16) = o1; }
}
#define ROWK(p, k0, rr) ((p) + (size_t)((k0) + (rr)) * KP + sc)
#define VMW() asm volatile("s_waitcnt vmcnt(0)" ::: "memory")
#define VMWN(n) asm volatile("s_waitcnt vmcnt(%0)" :: "i"(n) : "memory")
#define SLOAD_H(Kp, Vp, k0) do { S.st_v0 = load8(ROWK(Vp, k0, sr)); S.st_v1 = load8(ROWK(Vp, k0, 32 + sr));              \
                         S.st_k0 = load8(ROWK(Kp, k0, sr)); S.st_k1 = load8(ROWK(Kp, k0, 32 + sr)); } while (0)
#define OPQ_TID() int t_ = threadIdx.x; asm volatile("" : "+v"(t_)); const int sr_ = t_ >> 4, sc_ = (t_ & 15) * 8
#define SWRITE_HK(bf) do { OPQ_TID(); const int kws_ = KSWZ(sr_, sc_ * 2); *(bf16x8*)(K_lds + (bf) * SHM_K + kws_) = S.st_k0; *(bf16x8*)(K_lds + (bf) * SHM_K + kws_ + 32 * 256) = S.st_k1; } while (0)
#define SWRITE_HV(bf) do { OPQ_TID(); const int vst0_ = v_st(sr_, sc_), vst1_ = v_st(32 + sr_, sc_); *(bf16x8*)(V_lds + (bf) * SHM_V + vst0_) = S.st_v0; *(bf16x8*)(V_lds + (bf) * SHM_V + vst1_) = S.st_v1; } while (0)
#define SWRITE_H(bf) do { SWRITE_HV(bf); SWRITE_HK(bf); } while (0)
__device__ __forceinline__ void fox_prime(const BlockRef& cur, char* lds, char* cbcur, Seam& S) {
    const int tid = threadIdx.x, wid = __builtin_amdgcn_readfirstlane(tid >> 6), lane = tid & 63, r32 = lane & 31, hi = lane >> 5;
    const int sr = tid >> 4, sc = (tid & 15) * 8; char* K_lds = lds + 2 * SHM_V;
    for (int d0 = 0; d0 < 8; ++d0) S.qr[d0] = load8(cur.Q + (size_t)(wid * QBLK + r32) * QP + d0 * 16 + hi * 8);
    SLOAD_H(cur.K, cur.V, cur.P0 + QB - KVBLK); VMW(); SWRITE_HK(0);
    fill_cb(cur.C, cur.P0, cbcur);
    __syncthreads();
}
__device__ __forceinline__ void fox_block(const BlockRef& cur, const BlockRef& nxt, char* lds, char* cbcur, char* cbnxt, Seam& S) {
    const int tid = threadIdx.x, wid = __builtin_amdgcn_readfirstlane(tid >> 6), lane = tid & 63, r32 = lane & 31, hi = lane >> 5;
    const int W = 1 << 30;
    const int NT = (cur.P0 + QB) / KVBLK;
    const int qlo = cur.P0 + wid * QBLK, qm = qlo + r32 - 4 * hi;
    char* V_lds = lds; char* K_lds = lds + 2 * SHM_V;
    float* ws = (float*)(lds + LDS_WS_OFF) + wid * 64; float* li_l = ws, * al_l = ws + 32;
    float m_reg = -1e30f, l_reg = 0; f32x16 o[4] = {};
    const int sr = tid >> 4, sc = (tid & 15) * 8;
    const int vb0 = (int)(uintptr_t)V_lds + v_rd_base(lane);
    const bf16* Kh = cur.K; const bf16* Vh = cur.V;
    const char* cbl = cbcur + 8 * r32;
#define RESC(a) do { if (__any((a) < 1.f)) { if (hi == 0) al_l[r32] = (a); asm volatile("s_waitcnt lgkmcnt(0)" ::: "memory");              \
                     for (int d_ = 0; d_ < 4; ++d_) for (int r = 0; r < 16; ++r) o[d_][r] *= al_l[crow(r, hi)]; } } while (0)
#define KBASE(t) ((NT - 1 - (t)) * KVBLK)
#define MASKT(P0_, P1_, t) do { const int kb_ = KBASE(t); if (kb_ + KVBLK - 1 > qlo) mask_tile(P0_, P1_, qm - kb_, (unsigned)W); } while (0)
    constexpr int NQL = 8;
#define SEAM_K0() do { VMWN(NQL); SWRITE_HK(0); SBAR(); } while (0)
    f32x16 pA0, pA1, pB0, pB1; float mnA, mnB, alA, alB; bf16x8 pa0, pa1, pa2, pa3;
    SWRITE_HV(0); SBAR();
    if (NT > 1) { SLOAD_H(Kh, Vh, KBASE(1)); }
    SBAR(); qkt<0>(pA0, pA1, K_lds, cbl + 8 * KBASE(0), r32, hi, S.qr);
    MASKT(pA0, pA1, 0); partialSM(pA0, pA1, m_reg, mnA, alA);
    if (NT > 1) { VMW(); SWRITE_H(1); }
    __syncthreads();
#define HALF_STEP(PX0, PX1, mnX, alX, PY0, PY1, alY, t, KB, VB, SB) do {                                                      \
        SBAR(); if ((t) + 1 < NT) { SLOAD_H(Kh, Vh, KBASE((t) + 1)); SBAR(); }     \
        qkt<KB>(PX0, PX1, K_lds, cbl + 8 * KBASE(t), r32, hi, S.qr);                                             \
        finishSM(PY0, PY1, alY, l_reg, pa0, pa1, pa2, pa3); SBAR();                                                           \
        pv_tile<VB>(o, vb0, pa0, pa1, pa2, pa3); MASKT(PX0, PX1, (t)); partialSM(PX0, PX1, m_reg, mnX, alX);                                        \
        __syncthreads();                                                                                                      \
        if ((t) + 1 < NT) { VMW(); SWRITE_H(SB); }                                                                          \
        RESC(alX); __syncthreads(); } while (0)
    for (int t = 1; t + 1 < NT; t += 2) {
        HALF_STEP(pB0, pB1, mnB, alB, pA0, pA1, alA, t, 1, 0, 0);
        HALF_STEP(pA0, pA1, mnA, alA, pB0, pB1, alB, t + 1, 0, 1, 1);
    }
    const bool even = (NT & 1) == 0;
    if (even) { SBAR(); qkt<1>(pB0, pB1, K_lds, cbl + 8 * KBASE(NT - 1), r32, hi, S.qr); SBAR(); }
    SLOAD_H(nxt.K, nxt.V, nxt.P0 + QB - KVBLK); SBAR();
#pragma unroll
    for (int d0 = 0; d0 < 8; ++d0) S.qr[d0] = load8(nxt.Q + (size_t)(wid * QBLK + r32) * QP + d0 * 16 + hi * 8);
    SBAR();
    finishSM(pA0, pA1, alA, l_reg, pa0, pa1, pa2, pa3); SBAR();
    pv_tile<0>(o, vb0, pa0, pa1, pa2, pa3);
    if (even) { MASKT(pB0, pB1, NT - 1); partialSM(pB0, pB1, m_reg, mnB, alB); __syncthreads(); RESC(alB);
        finishSM(pB0, pB1, alB, l_reg, pa0, pa1, pa2, pa3); SBAR(); pv_tile<1>(o, vb0, pa0, pa1, pa2, pa3); }
    SBAR(); SEAM_K0();
    if (hi == 0) li_l[r32] = l_reg; asm volatile("s_waitcnt lgkmcnt(0)" ::: "memory");
    float rli[16];
#pragma unroll
    for (int r = 0; r < 16; ++r) rli[r] = __builtin_amdgcn_rcpf(li_l[crow(r, hi)]);
    {
        int ln = lane; asm volatile("" : "+v"(ln)); const int r32e = ln & 31, hie = ln >> 5;
        char* stg = lds + LDS_STG_OFF + wid * 4352;
        bf16* Ow = cur.O + (size_t)(wid * QBLK) * QP; const bf16* Zw = cur.Z + (size_t)(wid * QBLK) * ZP;
#pragma unroll
        for (int half = 0; half < 2; ++half) {
#pragma unroll
            for (int rr = 0; rr < 8; ++rr) { const int r = half * 8 + rr; const int lrow = (rr & 3) + 8 * (rr >> 2) + 4 * hie;
#pragma unroll
                for (int d0 = 0; d0 < 4; ++d0) *(unsigned short*)(stg + lrow * 272 + (d0 * 32 + r32e) * 2) = (unsigned short)cvtpk(o[d0][r] * rli[r], 0.f); }
            asm volatile("s_waitcnt lgkmcnt(0)" ::: "memory");
#pragma unroll
            for (int it = 0; it < 4; ++it) { const int lrow = it * 4 + (ln >> 4), ch = ln & 15, grow = half * 16 + lrow;
                const u32x4 ov = *(const u32x4*)(stg + lrow * 272 + ch * 16); const u32x4 z = *(const u32x4*)(Zw + (size_t)grow * ZP + ch * 8);
                u32x4 w;
                w.x = cvtpk(__uint_as_float(ov.x << 16) * __uint_as_float(z.x << 16), __uint_as_float(ov.x & 0xffff0000u) * __uint_as_float(z.x & 0xffff0000u));
                w.y = cvtpk(__uint_as_float(ov.y << 16) * __uint_as_float(z.y << 16), __uint_as_float(ov.y & 0xffff0000u) * __uint_as_float(z.y & 0xffff0000u));
                w.z = cvtpk(__uint_as_float(ov.z << 16) * __uint_as_float(z.z << 16), __uint_as_float(ov.z & 0xffff0000u) * __uint_as_float(z.z & 0xffff0000u));
                w.w = cvtpk(__uint_as_float(ov.w << 16) * __uint_as_float(z.w << 16), __uint_as_float(ov.w & 0xffff0000u) * __uint_as_float(z.w & 0xffff0000u));
                *(u32x4*)(Ow + (size_t)grow * QP + ch * 8) = w; }
            asm volatile("s_waitcnt lgkmcnt(0)" ::: "memory");
        }
    }
    fill_cb(nxt.C, nxt.P0, cbnxt);
    __syncthreads();
#undef RESC
#undef KBASE
#undef MASKT
#undef SEAM_K0
#undef HALF_STEP
}
#undef ROWK
#undef VMW
#undef VMWN
#undef SLOAD_H
#undef SWRITE_HK
#undef SWRITE_HV
#undef SWRITE_H
#undef OPQ_TID
#undef KSWZ
#undef SBAR

struct Tensors { const bf16* AO; const bf16* K; const bf16* V; const bf16* ZB; const float* C; };
__device__ __forceinline__ BlockRef make_ref(const Tensors& T, int bh, int qb) {
    const int b = bh >> 3, h = bh & 7; const size_t row0 = (size_t)b * SEQ + (size_t)qb * QB;
    BlockRef r;
    r.Q = T.AO + row0 * QP + 1024 + h * D; r.O = (bf16*)r.Q;
    r.K = T.K + (size_t)b * SEQ * KP + h * D; r.V = T.V + (size_t)b * SEQ * KP + h * D;
    r.Z = T.ZB + row0 * ZP + h * D; r.C = T.C + (size_t)bh * SEQ; r.P0 = qb * QB;
    return r;
}
__device__ __forceinline__ void fox_phase(char* lds, const Tensors& T, int vcu, int G) {
    constexpr int total = 64 * 8;
    int L = vcu; if (L >= total) return;
    int pass = 0, par = 0;
    char* cb0 = lds + LDS_CB_OFF;
    BlockRef cur = make_ref(T, L >> 3, L & 7);
    Seam S;
    fox_prime(cur, lds, cb0, S);
    for (;;) {
        const bool more_pass = pass == 0, more_item = L + G < total, last = !more_pass && !more_item;
        int passn = pass + 1, Ln = L;
        if (!more_pass) { passn = 0; Ln = more_item ? L + G : L; }
        const int qbn = passn ? 15 - (Ln & 7) : (Ln & 7);
        const BlockRef nxt = last ? cur : make_ref(T, Ln >> 3, qbn);
        fox_block(cur, nxt, lds, cb0, cb0, S);
        if (last) break;
        cur = nxt; pass = passn; L = Ln; par ^= 1;
    }
}
}

#ifndef MK_N_LAUNCHES
#define MK_N_LAUNCHES 1
#endif
constexpr int N_LAUNCHES = MK_N_LAUNCHES;
constexpr int N_PHASES = 7;
constexpr int NWAVES = 8;
constexpr int BATCH = 8, SEQ = 4096, DM = 1024, T = BATCH * SEQ, NIN = 9224, NH = 8;
constexpr int NP1 = 7168, NG = 2048;
constexpr float EPS = 1e-6f;
constexpr size_t MiB = 1u << 20;
constexpr size_t WS_SSQ = 0, WS_LOGF = 1 * MiB, WS_CC = 2 * MiB, WS_WSM = 3 * MiB;
constexpr size_t WS_W1 = 4 * MiB, WS_WG = 18 * MiB, WS_WAB = 22 * MiB, WS_WO = 26 * MiB;
constexpr size_t WS_AO = 32 * MiB, WS_VA = 160 * MiB, WS_ZA = 224 * MiB, WS_K = 288 * MiB, WS_V = 352 * MiB, WS_ZB = 416 * MiB, WS_END = 480 * MiB;
constexpr int RING_BYTES = 131072, LDS_BYTES = 147456;
static_assert(fa::LDS_BYTES <= LDS_BYTES, "attention LDS");

#define GAS __attribute__((address_space(1)))
#define LAS __attribute__((address_space(3)))
typedef unsigned short bf16;
typedef unsigned v4u __attribute__((ext_vector_type(4)));
typedef float f32x4 __attribute__((ext_vector_type(4)));
typedef short bf16x8 __attribute__((ext_vector_type(8)));
#define LDS_WAIT() asm volatile("s_waitcnt lgkmcnt(0)" ::: "memory")
__device__ __forceinline__ unsigned f2bf(float f) { unsigned u = __builtin_bit_cast(unsigned, f); return (u + 0x7fffu + ((u >> 16) & 1u)) >> 16; }
__device__ __forceinline__ unsigned pk2(float lo, float hi) { return pg8::cvt_pk_bf16_c(lo, hi); }
__device__ __forceinline__ float wave_sum(float v) {
#pragma unroll
    for (int o = 1; o < 64; o <<= 1) v += __shfl_xor(v, o);
    return v;
}
__device__ __forceinline__ void transpose_item(const float* W, int ldw, int nblk, bf16* WT, int ldt, LAS float* scr, int item, int lane) {
    const int kb = item / nblk, nb = item % nblk, k0 = 64 * kb, n0 = 32 * nb;
#pragma unroll 8
    for (int i = 0; i < 32; ++i) { const int kk = 2 * i + (lane >> 5); scr[kk * 33 + (lane & 31)] = W[(size_t)(k0 + kk) * ldw + n0 + (lane & 31)]; }
    LDS_WAIT(); asm volatile("" ::: "memory");
    const int c = lane & 7;
#pragma unroll
    for (int j = 0; j < 4; ++j) { const int n = (lane >> 3) + 8 * j; const LAS float* s = scr + (8 * c) * 33 + n;
        v4u o; o.x = pk2(s[0 * 33], s[1 * 33]); o.y = pk2(s[2 * 33], s[3 * 33]); o.z = pk2(s[4 * 33], s[5 * 33]); o.w = pk2(s[6 * 33], s[7 * 33]);
        *(GAS v4u*)(WT + (size_t)(n0 + n) * ldt + k0 + 8 * c) = o; }
    LDS_WAIT(); asm volatile("" ::: "memory");
}

#define XB_TMO      128
#define XB_XCNT(j)  (256  + 64 * (j))
#define XB_XSUB(j)  (1280 + 64 * (j))
#define XB_XGEN(j)  (2304 + 64 * (j))
#define XB_TOP      3328
#define XB_TOPGEN   3392
#define XCD_BAR_WORDS 3456
#define XB_SPIN_CAP (1u << 18)

__device__ __forceinline__ unsigned xb_ld(unsigned* p)              { return __hip_atomic_load(p, __ATOMIC_RELAXED, __HIP_MEMORY_SCOPE_AGENT); }
__device__ __forceinline__ unsigned xb_add(unsigned* p, unsigned v) { return __hip_atomic_fetch_add(p, v, __ATOMIC_RELAXED, __HIP_MEMORY_SCOPE_AGENT); }
__device__ __forceinline__ unsigned xb_xcc_id() { return (unsigned)__builtin_amdgcn_s_getreg((3 << 11) | 20) & 0xFu; }
#define XB_SPIN(cond, bar) do { unsigned _sp = 0; while (cond) { __builtin_amdgcn_s_sleep(1); \
    if ((++_sp & 255u) == 0u) { if (xb_ld(&(bar)[XB_TMO])) break; if (_sp > XB_SPIN_CAP) { atomicAdd(&(bar)[XB_TMO], 1u); break; } } } } while (0)

struct XcdBarrier {
    unsigned* bar; unsigned x;
    volatile LAS unsigned* st;
};

__device__ __forceinline__ XcdBarrier xcd_barrier_post(unsigned* bar, volatile LAS unsigned* st) {
    XcdBarrier b; b.bar = bar; b.x = xb_xcc_id(); b.st = st;
    if (threadIdx.x == 0) (void)xb_add(&bar[XB_XCNT(b.x)], 1u);
    return b;
}
__device__ __forceinline__ void xcd_barrier_complete(unsigned* bar, unsigned x, unsigned& nloc, unsigned& nx) {
    const unsigned G = gridDim.x * gridDim.y * gridDim.z;
    unsigned sum, cnt, mine, sp = 0u;
    for (;;) {
        sum = 0u; cnt = 0u; mine = 0u;
#pragma unroll
        for (unsigned j = 0; j < 16; ++j) { const unsigned c = xb_ld(&bar[XB_XCNT(j)]); sum += c; cnt += (c > 0u) ? 1u : 0u; mine = (j == x) ? c : mine; }
        if (sum == G) break;
        __builtin_amdgcn_s_sleep(1);
        if ((++sp & 255u) == 0u) { if (xb_ld(&bar[XB_TMO])) break; if (sp > XB_SPIN_CAP) { atomicAdd(&bar[XB_TMO], 1u); break; } }
    }
    nloc = mine > 0u ? mine : 1u; nx = cnt > 0u ? cnt : 1u;
}

__device__ __forceinline__ void xcd_barrier(const XcdBarrier& b) {
    asm volatile("s_waitcnt vmcnt(0)" ::: "memory");
    __syncthreads();
    if (threadIdx.x == 0) {
        unsigned* bar = b.bar;
        __builtin_amdgcn_s_waitcnt(0);
        unsigned nloc = b.st[0], nx = b.st[1];
        if (nloc == 0u) { xcd_barrier_complete(bar, b.x, nloc, nx); b.st[0] = nloc; b.st[1] = nx; }
        const unsigned old = xb_add(&bar[XB_XSUB(b.x)], 1u);
        const unsigned gen = old / nloc;
        if (old + 1u == (gen + 1u) * nloc) {
            __builtin_amdgcn_fence(__ATOMIC_RELEASE, "agent");
            asm volatile("s_waitcnt vmcnt(0)" ::: "memory");
            const unsigned og = xb_add(&bar[XB_TOP], 1u);
            const unsigned tg = og / nx;
            if (og + 1u == (tg + 1u) * nx) xb_add(&bar[XB_TOPGEN], 1u);
            else XB_SPIN(xb_ld(&bar[XB_TOPGEN]) == tg, bar);
            __builtin_amdgcn_fence(__ATOMIC_ACQUIRE, "agent");
            xb_add(&bar[XB_XGEN(b.x)], 1u);
            asm volatile("s_waitcnt vmcnt(0)" ::: "memory");
        } else {
            XB_SPIN(xb_ld(&bar[XB_XGEN(b.x)]) == gen, bar);
            __builtin_amdgcn_fence(__ATOMIC_ACQUIRE, "agent");
            asm volatile("s_waitcnt vmcnt(0)" ::: "memory");
        }
    }
    __syncthreads();
}

constexpr size_t WS_BAR = 512 * 1024, WS_CNT = WS_BAR + 16384; constexpr int BAR_BYTES = 16384 + 128 * 256, MISC_OFF = 147200;
static_assert(XCD_BAR_WORDS * 4 <= 16384 && fa::LDS_BYTES <= MISC_OFF, "barrier words / LDS map");
struct Args { const float* in[13]; float* out; unsigned char* ws; int ph_lo, ph_hi; };

__device__ __forceinline__ void p0_prologue(const Args& a, LAS unsigned char* lds, int vcu, int G, int tid, int lane, int wave) {
    unsigned char* ws = a.ws;
    const float* x = a.in[0]; const float* n1g = a.in[1]; const float* w_in = a.in[2]; const float* w_sp = a.in[5]; const float* b_f = a.in[7];
    const float* wpa = a.in[9]; const float* wpb = a.in[10]; const float* wout = a.in[11];
    bf16* W1t = (bf16*)(ws + WS_W1); bf16* WGt = (bf16*)(ws + WS_WG); bf16* WABt = (bf16*)(ws + WS_WAB); bf16* WOt = (bf16*)(ws + WS_WO);
    bf16* WSM = (bf16*)(ws + WS_WSM); float* ssq = (float*)(ws + WS_SSQ); float* logf_ = (float*)(ws + WS_LOGF);
    bf16* XN = (bf16*)a.out;
    const int gw = vcu * NWAVES + wave, NGW = G * NWAVES, gt = vcu * 512 + tid, NGT = G * 512;
    LAS float* wf = (LAS float*)(lds + 73728);
    for (int k = tid; k < 1024; k += 512) { const f32x4 w0 = *(const f32x4*)(w_in + (size_t)k * NIN + 7168), w1 = *(const f32x4*)(w_in + (size_t)k * NIN + 7172);
        wf[0 * 1024 + k] = w0.x; wf[1 * 1024 + k] = w0.y; wf[2 * 1024 + k] = w0.z; wf[3 * 1024 + k] = w0.w; wf[4 * 1024 + k] = w1.x; wf[5 * 1024 + k] = w1.y; wf[6 * 1024 + k] = w1.z; wf[7 * 1024 + k] = w1.w; }
    LAS float* scr = (LAS float*)(lds + wave * 8448);
    constexpr int I1 = 16 * (NP1 / 32), IG = 16 * (NG / 32), IS = 16 * 32;
    constexpr int NITEMS = I1 + IG + 3 * IS;
    for (int it = gw; it < NITEMS; it += NGW) {
        int r = it;
        if (r < I1) { transpose_item(w_in, NIN, NP1 / 32, W1t, 1024, scr, r, lane); continue; } r -= I1;
        if (r < IG) { transpose_item(w_in + 7176, NIN, NG / 32, WGt, 1024, scr, r, lane); continue; } r -= IG;
        if (r < IS) { transpose_item(wpa, 1024, 32, WABt, 2048, scr, r, lane); continue; } r -= IS;
        if (r < IS) { transpose_item(wpb, 1024, 32, WABt + 1024, 2048, scr, r, lane); continue; } r -= IS;
        transpose_item(wout, 1024, 32, WOt, 1024, scr, r, lane);
    }
    for (int i = gt; i < 8 * 128 * 128; i += NGT) { const int s = i & 127, t = (i >> 7) & 127; const float v = ((t >> 6) >= (s >> 6)) ? w_sp[i] : 0.f; WSM[i] = (bf16)f2bf(v); }
    for (int i = gt; i < T; i += NGT) ssq[i] = 0.f;
    __syncthreads();
    const GAS f32x4* gp = (const GAS f32x4*)n1g + lane;
    f32x4 gv[4];
#pragma unroll
    for (int j = 0; j < 4; ++j) gv[j] = gp[64 * j];
    f32x4 nv[4];
    if (gw < T) { const GAS f32x4* xr0 = (const GAS f32x4*)(x + (size_t)gw * DM) + lane;
#pragma unroll
        for (int j = 0; j < 4; ++j) nv[j] = xr0[64 * j]; }
    for (int m = gw; m < T; m += NGW) {
        f32x4 v[4]; float s2 = 0.f;
#pragma unroll
        for (int j = 0; j < 4; ++j) { v[j] = nv[j]; s2 += (v[j].x * v[j].x + v[j].y * v[j].y) + (v[j].z * v[j].z + v[j].w * v[j].w); }
        if (m + NGW < T) { const GAS f32x4* xr = (const GAS f32x4*)(x + (size_t)(m + NGW) * DM) + lane;
#pragma unroll
            for (int j = 0; j < 4; ++j) nv[j] = xr[64 * j]; }
        const float rstd = 1.0f / sqrtf(wave_sum(s2) * (1.f / DM) + EPS);
#pragma unroll
        for (int j = 0; j < 4; ++j) v[j] = v[j] * rstd * gv[j];
        GAS unsigned long long* o8 = (GAS unsigned long long*)(XN + (size_t)m * DM) + lane;
#pragma unroll
        for (int j = 0; j < 4; ++j) o8[64 * j] = (unsigned long long)pk2(v[j].x, v[j].y) | ((unsigned long long)pk2(v[j].z, v[j].w) << 32);
        float f[8];
#pragma unroll
        for (int h = 0; h < 8; ++h) { float acc = 0.f;
#pragma unroll
            for (int j = 0; j < 4; ++j) { const f32x4 w = *(const LAS f32x4*)(wf + h * 1024 + 256 * j + 4 * lane); acc += (v[j].x * w.x + v[j].y * w.y) + (v[j].z * w.z + v[j].w * w.w); }
            f[h] = wave_sum(acc); }
        float fz = f[0];
#pragma unroll
        for (int h = 1; h < 8; ++h) fz = (lane == h) ? f[h] : fz;
        if (lane < 8) { const float z = fz + b_f[lane]; const float ls = fminf(z, 0.f) - log1pf(expf(-fabsf(z)));
            const int b = m >> 12, s = m & 4095; logf_[((size_t)(b * NH + lane) << 12) + s] = ls; }
    }
}
__device__ __forceinline__ void cumsum_bh(const float* logf_, float* cc, int bh, LAS unsigned char* lds, int tid, int lane, int wave) {
    LAS float* wt = (LAS float*)lds;
    const float* src = logf_ + (size_t)bh * SEQ + tid * 8; float* dst = cc + (size_t)bh * SEQ + tid * 8;
    f32x4 a = *(const f32x4*)src, b = *(const f32x4*)(src + 4);
    a.y += a.x; a.z += a.y; a.w += a.z; b.x += a.w; b.y += b.x; b.z += b.y; b.w += b.z;
    float tot = b.w, inc = tot;
#pragma unroll
    for (int o = 1; o < 64; o <<= 1) { const float n = __shfl_up(inc, o); if (lane >= o) inc += n; }
    if (lane == 63) wt[wave] = inc;
    __syncthreads();
    float base = inc - tot;
    for (int w = 0; w < wave; ++w) base += wt[w];
    a = a + base; b = b + base;
    *(f32x4*)dst = a; *(f32x4*)(dst + 4) = b;
    __syncthreads();
}
constexpr int VN_PITCH = 260, YT_PITCH = 528, YT_OFF = 128 * VN_PITCH;
__device__ __forceinline__ void sgu_item(LAS unsigned char* lds, const bf16* VA, bf16* AO, const bf16* ZA, const bf16* WSM, const float* ln_g, const float* ln_b, const float* b_sp,
                                         int rb, int g, int tid, int lane, int wave, v4u (&vin)[4], int rbn, int gn, bool has_next) {
    const int r0 = rb * 128;
    v4u ureg[4], zreg[4];
    {
        const int row = tid >> 2, q = tid & 3;
        const v4u* up0 = (const v4u*)(AO + (size_t)(r0 + row) * 2048 + g * 128 + q * 32);
        const v4u* zp0 = (const v4u*)(ZA + (size_t)(r0 + row) * 1024 + g * 128 + q * 32);
#pragma unroll
        for (int i = 0; i < 4; ++i) { ureg[i] = up0[i]; zreg[i] = zp0[i]; }
    }
    {
        const int row = tid >> 2, q = tid & 3;
        float v[32];
#pragma unroll
        for (int i = 0; i < 4; ++i) { const v4u w = vin[i];
            v[8 * i + 0] = __uint_as_float(w.x << 16); v[8 * i + 1] = __uint_as_float(w.x & 0xffff0000u); v[8 * i + 2] = __uint_as_float(w.y << 16); v[8 * i + 3] = __uint_as_float(w.y & 0xffff0000u);
            v[8 * i + 4] = __uint_as_float(w.z << 16); v[8 * i + 5] = __uint_as_float(w.z & 0xffff0000u); v[8 * i + 6] = __uint_as_float(w.w << 16); v[8 * i + 7] = __uint_as_float(w.w & 0xffff0000u); }
        float s = 0.f;
#pragma unroll
        for (int i = 0; i < 32; ++i) s += v[i];
        s += __shfl_xor(s, 1); s += __shfl_xor(s, 2);
        const float mu = s * (1.f / 128.f); float s2 = 0.f;
#pragma unroll
        for (int i = 0; i < 32; ++i) { v[i] -= mu; s2 += v[i] * v[i]; }
        s2 += __shfl_xor(s2, 1); s2 += __shfl_xor(s2, 2);
        const float rstd = 1.0f / sqrtf(s2 * (1.f / 128.f) + EPS);
        const f32x4* gp = (const f32x4*)(ln_g + g * 128 + q * 32); const f32x4* bp = (const f32x4*)(ln_b + g * 128 + q * 32);
        LAS unsigned* dst = (LAS unsigned*)(lds + row * VN_PITCH + q * 64);
#pragma unroll
        for (int i = 0; i < 8; ++i) { const f32x4 gg = gp[i], bb = bp[i];
            dst[2 * i] = pk2(v[4 * i] * rstd * gg.x + bb.x, v[4 * i + 1] * rstd * gg.y + bb.y);
            dst[2 * i + 1] = pk2(v[4 * i + 2] * rstd * gg.z + bb.z, v[4 * i + 3] * rstd * gg.w + bb.w); }
    }
    __syncthreads();
    if (has_next) {
        const int row = tid >> 2, q = tid & 3;
        const v4u* vp = (const v4u*)(VA + (size_t)(rbn * 128 + row) * 1024 + gn * 128 + q * 32);
#pragma unroll
        for (int i = 0; i < 4; ++i) vin[i] = vp[i];
    }
    {
        const int fr = lane & 15, fq = lane >> 4, c = 16 * wave + fr;
        bf16x8 X[4];
#pragma unroll
        for (int kb = 0; kb < 4; ++kb) {
            const LAS unsigned short* p = (const LAS unsigned short*)(lds + (32 * kb + 8 * fq) * VN_PITCH + c * 2);
#pragma unroll
            for (int j = 0; j < 8; ++j) X[kb][j] = (short)p[j * (VN_PITCH / 2)];
        }
        const bf16* wg = WSM + (size_t)g * 16384 + fr * 128 + 8 * fq;
        f32x4 acc[8];
#pragma unroll
        for (int m = 0; m < 8; ++m) { acc[m] = (f32x4){0.f, 0.f, 0.f, 0.f};
#pragma unroll
            for (int kb = 0; kb < 4; ++kb) { if (m < 4 && kb >= 2) continue;
                const bf16x8 Y = *(const bf16x8*)(wg + m * 2048 + kb * 32);
                acc[m] = __builtin_amdgcn_mfma_f32_16x16x32_bf16(X[kb], Y, acc[m], 0, 0, 0); } }
#pragma unroll
        for (int m = 0; m < 8; ++m) { const int t = 16 * m + fr; const float bs = b_sp[g * 128 + t];
            *(LAS f32x4*)(lds + YT_OFF + t * YT_PITCH + (16 * wave + 4 * fq) * 4) = acc[m] + bs; }
    }
    __syncthreads();
    {
        const int row = tid >> 2, q = tid & 3;
        v4u* up = (v4u*)(AO + (size_t)(r0 + row) * 2048 + g * 128 + q * 32);
        const LAS f32x4* yp = (const LAS f32x4*)(lds + YT_OFF + row * YT_PITCH + q * 128);
#pragma unroll
        for (int i = 0; i < 4; ++i) { const v4u u = ureg[i], z = zreg[i]; const f32x4 y0 = yp[2 * i], y1 = yp[2 * i + 1];
            v4u o;
            o.x = pk2(__uint_as_float(u.x << 16) * y0.x * __uint_as_float(z.x << 16), __uint_as_float(u.x & 0xffff0000u) * y0.y * __uint_as_float(z.x & 0xffff0000u));
            o.y = pk2(__uint_as_float(u.y << 16) * y0.z * __uint_as_float(z.y << 16), __uint_as_float(u.y & 0xffff0000u) * y0.w * __uint_as_float(z.y & 0xffff0000u));
            o.z = pk2(__uint_as_float(u.z << 16) * y1.x * __uint_as_float(z.z << 16), __uint_as_float(u.z & 0xffff0000u) * y1.y * __uint_as_float(z.z & 0xffff0000u));
            o.w = pk2(__uint_as_float(u.w << 16) * y1.z * __uint_as_float(z.w << 16), __uint_as_float(u.w & 0xffff0000u) * y1.w * __uint_as_float(z.w & 0xffff0000u));
            up[i] = o; }
    }
}


__global__ void __launch_bounds__(NWAVES * 64, 2) fwd_mega(Args args) {
    extern __shared__ __attribute__((aligned(16))) unsigned char lds_raw[];
    LAS unsigned char* lds = (LAS unsigned char*)lds_raw;
    __builtin_assume(__builtin_amdgcn_workitem_id_y() == 0); __builtin_assume(__builtin_amdgcn_workitem_id_z() == 0);
    const int wave = __builtin_amdgcn_readfirstlane(threadIdx.x >> 6);
#define PH_IDS() int tid = threadIdx.x; asm volatile("" : "+v"(tid)); const int lane = tid & 63
    const int G = gridDim.x; const int bx = blockIdx.x; const int vcu = (G % 8 == 0) ? (bx % 8) * (G / 8) + bx / 8 : bx;
    unsigned char* ws = args.ws;
    const int lo = args.ph_lo, hi = args.ph_hi;
#define IN(k) (lo <= (k) && (k) < hi)
#define SEAM(k) do { if (IN(k) && IN((k) + 1)) { if ((k) == 0) cg::this_grid().sync(); else xcd_barrier(xbar); } } while (0)
    { volatile LAS unsigned* m_ = (volatile LAS unsigned*)(lds + MISC_OFF); if (threadIdx.x < 16) m_[threadIdx.x] = 0u; }
    __syncthreads();
    if (lo == 0) { unsigned* bz = (unsigned*)(ws + WS_BAR); for (int i = blockIdx.x * (NWAVES * 64) + threadIdx.x; i < BAR_BYTES / 4; i += gridDim.x * (NWAVES * 64)) bz[i] = 0u; }
    XcdBarrier xbar; xbar.bar = (unsigned*)(ws + WS_BAR); xbar.x = 0; xbar.st = (volatile LAS unsigned*)(lds + MISC_OFF);
    bf16* XN = (bf16*)args.out;
    bf16* AO = (bf16*)(ws + WS_AO); bf16* VA = (bf16*)(ws + WS_VA); bf16* ZA = (bf16*)(ws + WS_ZA); bf16* KB = (bf16*)(ws + WS_K); bf16* VB = (bf16*)(ws + WS_V); bf16* ZB = (bf16*)(ws + WS_ZB);
    bf16* GA = VA; bf16* GB = ZA; bf16* MG = KB;
    float* ssq = (float*)(ws + WS_SSQ); float* logf_ = (float*)(ws + WS_LOGF); float* cc = (float*)(ws + WS_CC);

    if (IN(0)) { PH_IDS(); p0_prologue(args, lds, vcu, G, tid, lane, wave); __syncthreads(); }
    SEAM(0);
    xbar = xcd_barrier_post((unsigned*)(ws + WS_BAR), (volatile LAS unsigned*)(lds + MISC_OFF));
    if (IN(1)) {
        { PH_IDS(); for (int bh = vcu; bh < BATCH * NH; bh += G) cumsum_bh(logf_, cc, bh, lds, tid, lane, wave); }
        pg8::Gemm g{XN, (const bf16*)(ws + WS_W1), T, NP1, DM}; pg8::StaticOrder S; S.init(T, NP1, G, bx);
        pg8::EpiP1 E{AO, VA, ZA, KB, VB, ZB};
        pg8::gemm_phase<pg8::EpiP1, pg8::StaticOrder, true, true>(lds, g, S, E);
    }
    SEAM(1);
    if (IN(2)) {
        const bf16* WSM = (const bf16*)(ws + WS_WSM);
        const fa::Tensors FT{AO, KB, VB, ZB, cc};
        if (vcu & 1) { fa::fox_phase((char*)lds_raw, FT, vcu, G); __syncthreads(); { PH_IDS(); v4u vin[4];
                if (vcu < 2048) { const v4u* vp = (const v4u*)(VA + (size_t)((vcu >> 3) * 128 + (tid >> 2)) * 1024 + (vcu & 7) * 128 + (tid & 3) * 32);
#pragma unroll
                    for (int i = 0; i < 4; ++i) vin[i] = vp[i]; }
                for (int it = vcu; it < 2048; it += G) { const int itn = it + G; sgu_item(lds, VA, AO, ZA, WSM, args.in[3], args.in[4], args.in[6], it >> 3, it & 7, tid, lane, wave, vin, itn >> 3, itn & 7, itn < 2048); } } }
        else { { PH_IDS(); v4u vin[4];
                if (vcu < 2048) { const v4u* vp = (const v4u*)(VA + (size_t)((vcu >> 3) * 128 + (tid >> 2)) * 1024 + (vcu & 7) * 128 + (tid & 3) * 32);
#pragma unroll
                    for (int i = 0; i < 4; ++i) vin[i] = vp[i]; }
                for (int it = vcu; it < 2048; it += G) { const int itn = it + G; sgu_item(lds, VA, AO, ZA, WSM, args.in[3], args.in[4], args.in[6], it >> 3, it & 7, tid, lane, wave, vin, itn >> 3, itn & 7, itn < 2048); } } __syncthreads(); fa::fox_phase((char*)lds_raw, FT, vcu, G); }
    }
    SEAM(2);
    if (IN(3)) {
        pg8::Gemm g{XN, (const bf16*)(ws + WS_WG), T, NG, DM}; pg8::StaticOrder S; S.init(T, NG, G, bx);
        pg8::EpiGate E{GA, GB, args.in[8]};
        pg8::gemm_phase<pg8::EpiGate, pg8::StaticOrder, true, true>(lds, g, S, E);
    }
    if (G != 256) SEAM(3);
    if (IN(4)) {
        pg8::Gemm g{AO, (const bf16*)(ws + WS_WAB), T, DM, 2 * DM}; pg8::StaticOrder S; S.init(T, DM, G, bx);
        pg8::EpiMerged E{GA, GB, MG};
        pg8::gemm_phase<pg8::EpiMerged, pg8::StaticOrder, true, true>(lds, g, S, E);
    }
    SEAM(4);
    if (IN(5)) {
        pg8::Gemm g{MG, (const bf16*)(ws + WS_WO), T, DM, DM}; pg8::StaticOrder S; S.init(T, DM, G, bx);
        if (N_LAUNCHES == 1) { pg8::EpiOutNorm E{args.in[0], args.out, ssq, (unsigned*)(ws + WS_CNT), args.in[12], EPS};
            pg8::gemm_phase<pg8::EpiOutNorm, pg8::StaticOrder, true, true>(lds, g, S, E); }
        else { pg8::EpiOut E{args.in[0], args.out, ssq};
            pg8::gemm_phase<pg8::EpiOut, pg8::StaticOrder, true, true>(lds, g, S, E); }
    }
    if (N_LAUNCHES != 1) SEAM(5);
    if (IN(6) && N_LAUNCHES != 1) {
        PH_IDS(); const float* nfg = args.in[12];
        const int gw = vcu * NWAVES + wave, NGW = G * NWAVES;
        const GAS f32x4* gp = (const GAS f32x4*)nfg + lane;
        f32x4 gv[4];
#pragma unroll
        for (int j = 0; j < 4; ++j) gv[j] = gp[64 * j];
        for (int m = gw; m < T; m += NGW) {
            GAS f32x4* hr = (GAS f32x4*)(args.out + (size_t)m * DM) + lane;
            const float rstd = 1.0f / sqrtf(ssq[m] * (1.f / DM) + EPS);
#pragma unroll
            for (int j = 0; j < 4; ++j) { const f32x4 h = hr[64 * j]; hr[64 * j] = h * rstd * gv[j]; }
        }
    }
#undef IN
#undef SEAM
}


extern "C" void kernel_launch(void* const* d_in, const int* in_sizes, int n_in, void* d_out, int out_size, void* d_ws, size_t ws_size, hipStream_t stream) {
    static int grid = 0;
    if (grid == 0) {
        if (n_in != 13 || in_sizes[0] != T * DM || out_size != T * DM || ws_size < WS_END) { fprintf(stderr, "kernel_launch: shape/workspace mismatch (n_in %d, in0 %d, out %d, ws %zu)\n", n_in, n_in > 0 ? in_sizes[0] : -1, out_size, ws_size); grid = -1; return; }
        int dev = 0, cus = 0, per_cu = 0;
        if (hipGetDevice(&dev) != hipSuccess || hipDeviceGetAttribute(&cus, hipDeviceAttributeMultiprocessorCount, dev) != hipSuccess) { grid = -1; return; }
        if (hipFuncSetAttribute((const void*)fwd_mega, hipFuncAttributeMaxDynamicSharedMemorySize, LDS_BYTES) != hipSuccess) { fprintf(stderr, "kernel_launch: hipFuncSetAttribute failed\n"); grid = -1; return; }
        if (hipOccupancyMaxActiveBlocksPerMultiprocessor(&per_cu, (const void*)fwd_mega, NWAVES * 64, LDS_BYTES) != hipSuccess || per_cu < 1) { fprintf(stderr, "kernel_launch: occupancy query says %d\n", per_cu); per_cu = 1; }
        (void)hipGetLastError();
        grid = cus;
    }
    if (grid < 0) return;
    Args a{};
    for (int i = 0; i < 13; ++i) a.in[i] = (const float*)d_in[i];
    a.out = (float*)d_out; a.ws = (unsigned char*)d_ws;
    if (N_LAUNCHES == 1) {
        a.ph_lo = 0; a.ph_hi = N_PHASES;
        void* kargs[] = {&a};
        hipError_t e = hipLaunchCooperativeKernel((const void*)fwd_mega, dim3(grid), dim3(NWAVES * 64), kargs, LDS_BYTES, stream);
        if (e != hipSuccess) fprintf(stderr, "kernel_launch: cooperative launch failed: %s (grid %d)\n", hipGetErrorString(e), grid);
    } else {
        for (int p = 0; p < N_PHASES; ++p) { a.ph_lo = p; a.ph_hi = p + 1; hipLaunchKernelGGL(fwd_mega, dim3(grid), dim3(NWAVES * 64), LDS_BYTES, stream, a); }
    }
}
```

```cpp
#include <hip/hip_runtime.h>
#include <hip/hip_cooperative_groups.h>
#include <cstdio>
#include <cstdint>
#include <cmath>
namespace cg = cooperative_groups;
namespace pg8 {
#define PG8_LAS __attribute__((address_space(3)))
typedef unsigned short bf16_t;
typedef short bf16x8 __attribute__((ext_vector_type(8)));
typedef float f32x4 __attribute__((ext_vector_type(4)));
typedef unsigned u32x4 __attribute__((ext_vector_type(4)));
constexpr int BM = 256, BK = 64, HALF = 128, HTB = HALF * BK * 2  , STAGE_BYTES = 8 * HTB, NXCD = 8, WGM = 8;

__host__ __device__ __forceinline__ int lds_byte(int r, int c) { const int st = (r >> 4) * 2 + (c >> 5), rr = r & 15, cc = c & 31, ob = rr * 64 + cc * 2; return st * 1024 + (ob ^ (((ob >> 9) & 1) << 5)); }
__host__ __device__ __forceinline__ void stage_rc(int b, int& R, int& C) { const int st = b / 1024, sb = b % 1024, swz = sb ^ (((sb >> 9) & 1) << 5); R = (st >> 1) * 16 + swz / 64; C = (st & 1) * 32 + (swz % 64) / 2; }
__host__ __device__ __forceinline__ int perm32(int rho) { const int n = rho >> 4, i = rho & 15; return 8 * (i >> 2) + 4 * n + (i & 3); }

struct Unit { int pm, pn; };
struct Gemm { const bf16_t* A; const bf16_t* Bt; int M, N, K; };

struct StaticOrder {
    int nM, nN, nwg, G, c;
    __host__ __device__ void init(int M, int N, int G_, int c_) { nM = M / BM; nN = N / BM; nwg = nM * nN; G = G_; c = c_; }
    __host__ __device__ bool next(int i, Unit& u) const {
        const long L = (long)i * G + c; if (L >= nwg) return false;
        int wgid = (int)L; { const int q = nwg / NXCD, r = nwg % NXCD, xcd = wgid % NXCD, off = wgid / NXCD; wgid = (xcd < r ? xcd * (q + 1) : r * (q + 1) + (xcd - r) * q) + off; }
        const int nig = WGM * nN, gid = wgid / nig, fm = gid * WGM, gsz = (nM - fm) < WGM ? (nM - fm) : WGM;
        u.pm = fm + ((wgid % nig) % gsz); u.pn = (wgid % nig) / gsz; return true;
    }
    __device__ __forceinline__ void a_ready(const Unit&) const {}
    __device__ __forceinline__ void done(const Unit&) const {}
};

__device__ __forceinline__ unsigned cvt_pk_bf16(float lo, float hi) { unsigned r; asm volatile("v_cvt_pk_bf16_f32 %0, %1, %2" : "=v"(r) : "v"(lo), "v"(hi)); return r; }
typedef float f32x2 __attribute__((ext_vector_type(2)));

__device__ __forceinline__ float silu_f(float v) { return v * __builtin_amdgcn_rcpf(1.0f + __builtin_amdgcn_exp2f(-1.4426950408889634f * v)); }
__device__ __forceinline__ float sigm_f(float v) { return __builtin_amdgcn_rcpf(1.0f + __builtin_amdgcn_exp2f(-1.4426950408889634f * v)); }
typedef float f32x2c_t __attribute__((ext_vector_type(2))); typedef __bf16 bf16x2c_t __attribute__((ext_vector_type(2)));
__device__ __forceinline__ unsigned cvt_pk_bf16_c(float lo, float hi) { f32x2c_t v = {lo, hi}; bf16x2c_t b = __builtin_convertvector(v, bf16x2c_t); return __builtin_bit_cast(unsigned, b); }
__device__ __forceinline__ float bf_lo(unsigned w) { return __uint_as_float(w << 16); }
__device__ __forceinline__ float bf_hi(unsigned w) { return __uint_as_float(w & 0xffff0000u); }

struct EpiP1 {
    static constexpr bool PERM = true, AFTER_DRAIN = false, HAS_MID = false; static constexpr int MID_T = -1;
    bf16_t *AO, *VA, *ZA, *KB, *VB, *ZB;
    __device__ __forceinline__ void mid(f32x4 (&)[2][2][4][2], const Unit&, int, int, int, int) const {}
    __device__ __forceinline__ void operator()(const f32x4 (&acc)[2][2][4][2], const Unit& u, int wr, int wc, int fr, int fq) const {
        const int g = u.pn >> 2, cin = (u.pn & 3) * BM;
        bf16_t* base = g == 0 ? AO : g == 1 ? VA : g == 2 ? ZA : g == 3 ? AO + 1024 : g == 4 ? KB : g == 5 ? VB : ZB;
        const int ldc = (g == 0 || g == 3) ? 2048 : 1024;
        const bool act = (g == 2 || g == 6);
        const int row0 = u.pm * BM + wr * 64 + fr, col0 = cin + wc * 32 + 8 * fq;
#pragma unroll
        for (int ai = 0; ai < 2; ++ai)
#pragma unroll
            for (int m = 0; m < 4; ++m) { bf16_t* rowp = base + (size_t)(row0 + ai * HALF + m * 16) * ldc + col0;
#pragma unroll
                for (int bj = 0; bj < 2; ++bj) { f32x4 v0 = acc[ai][bj][m][0], v1 = acc[ai][bj][m][1];
                    if (act) {
#pragma unroll
                        for (int e = 0; e < 4; ++e) { v0[e] = silu_f(v0[e]); v1[e] = silu_f(v1[e]); } }
                    u32x4 w; w.x = cvt_pk_bf16(v0[0], v0[1]); w.y = cvt_pk_bf16(v0[2], v0[3]); w.z = cvt_pk_bf16(v1[0], v1[1]); w.w = cvt_pk_bf16(v1[2], v1[3]);
                    *(u32x4*)(rowp + bj * HALF) = w; } }
    }
};
struct EpiGate {
    static constexpr bool PERM = true, AFTER_DRAIN = false, HAS_MID = false; static constexpr int MID_T = -1;
    bf16_t *GA, *GB; const float* bias;
    __device__ __forceinline__ void mid(f32x4 (&)[2][2][4][2], const Unit&, int, int, int, int) const {}
    __device__ __forceinline__ void operator()(const f32x4 (&acc)[2][2][4][2], const Unit& u, int wr, int wc, int fr, int fq) const {
        const int g = u.pn >> 2, cin = (u.pn & 3) * BM;
        bf16_t* base = g == 0 ? GA : GB;
        const int row0 = u.pm * BM + wr * 64 + fr, col0 = cin + wc * 32 + 8 * fq, bcol0 = u.pn * BM + wc * 32 + 8 * fq;
        f32x4 bv[2][2];
#pragma unroll
        for (int bj = 0; bj < 2; ++bj)
#pragma unroll
            for (int n = 0; n < 2; ++n) bv[bj][n] = *(const f32x4*)(bias + bcol0 + bj * HALF + 4 * n);
#pragma unroll
        for (int ai = 0; ai < 2; ++ai)
#pragma unroll
            for (int m = 0; m < 4; ++m) { bf16_t* rowp = base + (size_t)(row0 + ai * HALF + m * 16) * 1024 + col0;
#pragma unroll
                for (int bj = 0; bj < 2; ++bj) { f32x4 v0 = acc[ai][bj][m][0] + bv[bj][0], v1 = acc[ai][bj][m][1] + bv[bj][1];
#pragma unroll
                    for (int e = 0; e < 4; ++e) { v0[e] = sigm_f(v0[e]); v1[e] = sigm_f(v1[e]); }
                    u32x4 w; w.x = cvt_pk_bf16_c(v0[0], v0[1]); w.y = cvt_pk_bf16_c(v0[2], v0[3]); w.z = cvt_pk_bf16_c(v1[0], v1[1]); w.w = cvt_pk_bf16_c(v1[2], v1[3]);
                    *(u32x4*)(rowp + bj * HALF) = w; } }
    }
};
struct EpiMerged {
    static constexpr bool PERM = true, AFTER_DRAIN = false, HAS_MID = true; static constexpr int MID_T = 16;
    const bf16_t *GA, *GB; bf16_t* MG;
    __device__ __forceinline__ void mid(f32x4 (&acc)[2][2][4][2], const Unit& u, int wr, int wc, int fr, int fq) const {
        asm volatile("" : "+v"(fr), "+v"(fq));
        const int row0 = u.pm * BM + wr * 64 + fr, col0 = u.pn * BM + wc * 32 + 8 * fq;
#pragma unroll
        for (int ai = 0; ai < 2; ++ai)
#pragma unroll
            for (int m = 0; m < 4; ++m) { const size_t off = (size_t)(row0 + ai * HALF + m * 16) * 1024 + col0;
#pragma unroll
                for (int bj = 0; bj < 2; ++bj) { const u32x4 a = *(const u32x4*)(GA + off + bj * HALF), b = *(const u32x4*)(GB + off + bj * HALF);
                    f32x4 r0, r1;
                    r0[0] = bf_lo(a.x) * __builtin_amdgcn_rcpf(bf_lo(b.x)); r0[1] = bf_hi(a.x) * __builtin_amdgcn_rcpf(bf_hi(b.x));
                    r0[2] = bf_lo(a.y) * __builtin_amdgcn_rcpf(bf_lo(b.y)); r0[3] = bf_hi(a.y) * __builtin_amdgcn_rcpf(bf_hi(b.y));
                    r1[0] = bf_lo(a.z) * __builtin_amdgcn_rcpf(bf_lo(b.z)); r1[1] = bf_hi(a.z) * __builtin_amdgcn_rcpf(bf_hi(b.z));
                    r1[2] = bf_lo(a.w) * __builtin_amdgcn_rcpf(bf_lo(b.w)); r1[3] = bf_hi(a.w) * __builtin_amdgcn_rcpf(bf_hi(b.w));
                    acc[ai][bj][m][0] *= r0; acc[ai][bj][m][1] *= r1; }
                if (m & 1) asm volatile("" ::: "memory"); }
    }
    __device__ __forceinline__ void operator()(const f32x4 (&acc)[2][2][4][2], const Unit& u, int wr, int wc, int fr, int fq) const {
        const int row0 = u.pm * BM + wr * 64 + fr, col0 = u.pn * BM + wc * 32 + 8 * fq;
#pragma unroll
        for (int ai = 0; ai < 2; ++ai)
#pragma unroll
            for (int m = 0; m < 4; ++m) { const size_t off = (size_t)(row0 + ai * HALF + m * 16) * 1024 + col0;
#pragma unroll
                for (int bj = 0; bj < 2; ++bj) { const u32x4 b = *(const u32x4*)(GB + off + bj * HALF);
                    const f32x4 v0 = acc[ai][bj][m][0], v1 = acc[ai][bj][m][1];
                    u32x4 w; w.x = cvt_pk_bf16(v0[0] * bf_lo(b.x), v0[1] * bf_hi(b.x)); w.y = cvt_pk_bf16(v0[2] * bf_lo(b.y), v0[3] * bf_hi(b.y));
                    w.z = cvt_pk_bf16(v1[0] * bf_lo(b.z), v1[1] * bf_hi(b.z)); w.w = cvt_pk_bf16(v1[2] * bf_lo(b.w), v1[3] * bf_hi(b.w));
                    *(u32x4*)(MG + off + bj * HALF) = w; } }
    }
};

struct EpiOutNorm {
    static constexpr bool PERM = false, AFTER_DRAIN = false, HAS_MID = false; static constexpr int MID_T = -1;
    const float* x; float* out; float* ssq; unsigned* cnt; const float* gw; float eps;
    __device__ __forceinline__ void mid(f32x4 (&)[2][2][4][2], const Unit&, int, int, int, int) const {}
    __device__ __forceinline__ void operator()(f32x4 (&acc)[2][2][4][2], const Unit& u, int wr, int wc, int fr, int fq) const {
        const int row0 = u.pm * BM + wr * 64 + fr, col0 = u.pn * BM + wc * 32 + 4 * fq;
#pragma unroll
        for (int ai = 0; ai < 2; ++ai)
#pragma unroll
            for (int m = 0; m < 4; ++m) { const int row = row0 + ai * HALF + m * 16; const size_t off = (size_t)row * 1024 + col0; float s = 0.f;
#pragma unroll
                for (int bj = 0; bj < 2; ++bj)
#pragma unroll
                    for (int n = 0; n < 2; ++n) { const f32x4 xv = *(const f32x4*)(x + off + bj * HALF + n * 16); const f32x4 h = xv + acc[ai][bj][m][n]; acc[ai][bj][m][n] = h;
                        s += (h[0] * h[0] + h[1] * h[1]) + (h[2] * h[2] + h[3] * h[3]); }
                s += __shfl_xor(s, 16); s += __shfl_xor(s, 32);
                if (fq == 0) __hip_atomic_fetch_add(ssq + row, s, __ATOMIC_RELAXED, __HIP_MEMORY_SCOPE_AGENT);
                asm volatile("" ::: "memory"); }
        asm volatile("s_waitcnt vmcnt(0)" ::: "memory");
        unsigned* c = cnt + 64 * u.pm;
        if ((threadIdx.x & 63) == 0) __hip_atomic_fetch_add(c, 1u, __ATOMIC_RELAXED, __HIP_MEMORY_SCOPE_AGENT);
        { unsigned sp = 0; while ((unsigned)__builtin_amdgcn_readfirstlane(__hip_atomic_load(c, __ATOMIC_RELAXED, __HIP_MEMORY_SCOPE_AGENT)) < 32u) { __builtin_amdgcn_s_sleep(2); if (++sp > (1u << 22)) break; } }
        asm volatile("" ::: "memory");
        f32x4 gv[2][2];
#pragma unroll
        for (int bj = 0; bj < 2; ++bj)
#pragma unroll
            for (int n = 0; n < 2; ++n) gv[bj][n] = *(const f32x4*)(gw + col0 + bj * HALF + n * 16);
#pragma unroll
        for (int ai = 0; ai < 2; ++ai)
#pragma unroll
            for (int m = 0; m < 4; ++m) { const int row = row0 + ai * HALF + m * 16; const size_t off = (size_t)row * 1024 + col0;
                const float ss = __hip_atomic_load(ssq + row, __ATOMIC_RELAXED, __HIP_MEMORY_SCOPE_AGENT);
                const float rstd = 1.0f / sqrtf(ss * (1.0f / 1024.0f) + eps);
#pragma unroll
                for (int bj = 0; bj < 2; ++bj)
#pragma unroll
                    for (int n = 0; n < 2; ++n) *(f32x4*)(out + off + bj * HALF + n * 16) = acc[ai][bj][m][n] * rstd * gv[bj][n]; }
    }
};
struct EpiOut {
    static constexpr bool PERM = false, AFTER_DRAIN = false, HAS_MID = false; static constexpr int MID_T = -1;
    const float* x; float* out; float* ssq;
    __device__ __forceinline__ void mid(f32x4 (&)[2][2][4][2], const Unit&, int, int, int, int) const {}
    __device__ __forceinline__ void operator()(const f32x4 (&acc)[2][2][4][2], const Unit& u, int wr, int wc, int fr, int fq) const {
        const int row0 = u.pm * BM + wr * 64 + fr, col0 = u.pn * BM + wc * 32 + 4 * fq;
#pragma unroll
        for (int ai = 0; ai < 2; ++ai)
#pragma unroll
            for (int m = 0; m < 4; ++m) { const int row = row0 + ai * HALF + m * 16; const size_t off = (size_t)row * 1024 + col0; float s = 0.f;
#pragma unroll
                for (int bj = 0; bj < 2; ++bj)
#pragma unroll
                    for (int n = 0; n < 2; ++n) { const f32x4 xv = *(const f32x4*)(x + off + bj * HALF + n * 16); const f32x4 h = xv + acc[ai][bj][m][n];
                        s += (h[0] * h[0] + h[1] * h[1]) + (h[2] * h[2] + h[3] * h[3]); *(f32x4*)(out + off + bj * HALF + n * 16) = h; }
                s += __shfl_xor(s, 16); s += __shfl_xor(s, 32);
                if (fq == 0) atomicAdd(ssq + row, s); }
    }
};
template <class Epi, class Sched, bool ALIGN_EPI = false, bool SP2 = false>
__device__ __forceinline__ void gemm_phase(PG8_LAS unsigned char* lds, const Gemm g, const Sched& S, const Epi& E) {
    const int tid = threadIdx.x, wid = __builtin_amdgcn_readfirstlane(tid >> 6), lane = tid & 63, wr = wid >> 2, wc = wid & 3, fr = lane & 15, fq = lane >> 4;
    const int K = g.K, nt = K / BK;
    unsigned voffA[2], voffB[2];
#pragma unroll
    for (int i = 0; i < 2; ++i) { int R, C; stage_rc(tid * 16 + i * 8192, R, C); const int Rb = Epi::PERM ? ((R & ~31) + perm32(R & 31)) : R;
        voffA[i] = (unsigned)(R * K + C) * 2u; voffB[i] = (unsigned)(Rb * K + C) * 2u; }
    const size_t kstep = (size_t)(BK * 2);
    const size_t hstep = (size_t)HALF * K * 2;
    const size_t tstep = 2 * hstep;
    const unsigned ldsw = (unsigned)wid * 1024u;
    const int aoff = lds_byte(wr * 64 + fr, fq * 8), boff = lds_byte(wc * 32 + fr, fq * 8);
#define PG8_SA(b, h) (((b) * 2 + (h)) * HTB)
#define PG8_SB(b, h) ((4 + (b) * 2 + (h)) * HTB)
#define PG8_STAGE(bufoff, gbase, voff) do { _Pragma("unroll") for (int _i = 0; _i < 2; ++_i) \
        __builtin_amdgcn_global_load_lds((const unsigned*)((const char*)(gbase) + (voff)[_i]), (PG8_LAS unsigned*)(lds + (bufoff) + ldsw + _i * 8192), 16, 0, 0); } while (0)
#define PG8_LDA(dst, b, h) do { _Pragma("unroll") for (int m = 0; m < 4; ++m) _Pragma("unroll") for (int k = 0; k < 2; ++k) dst[m][k] = *(const PG8_LAS bf16x8*)(lds + PG8_SA(b, h) + aoff + m * 2048 + k * 1024); } while (0)
#define PG8_LDB(dst, b, h) do { _Pragma("unroll") for (int n = 0; n < 2; ++n) _Pragma("unroll") for (int k = 0; k < 2; ++k) dst[n][k] = *(const PG8_LAS bf16x8*)(lds + PG8_SB(b, h) + boff + n * 2048 + k * 1024); } while (0)
#define PG8_MMA(ai, bj, At, Bt) do { __builtin_amdgcn_s_setprio(1); _Pragma("unroll") for (int m = 0; m < 4; ++m) _Pragma("unroll") for (int n = 0; n < 2; ++n) _Pragma("unroll") for (int k = 0; k < 2; ++k) \
        acc[ai][bj][m][n] = __builtin_amdgcn_mfma_f32_16x16x32_bf16(Bt[n][k], At[m][k], acc[ai][bj][m][n], 0, 0, 0); __builtin_amdgcn_s_setprio(0); } while (0)
#define PG8_WAIT_V(n) asm volatile("s_waitcnt vmcnt(" #n ")" ::: "memory")
#define PG8_WAIT_L(n) asm volatile("s_waitcnt lgkmcnt(" #n ")" ::: "memory")
#define PG8_BAR __builtin_amdgcn_s_barrier()
#define PG8_SCHED __builtin_amdgcn_sched_barrier(0)
    Unit cur, nxt; int ui = 0;
    if (!S.next(0, cur)) return;
    f32x4 acc[2][2][4][2];
#pragma unroll
    for (int a = 0; a < 2; ++a)
#pragma unroll
        for (int b = 0; b < 2; ++b)
#pragma unroll
            for (int m = 0; m < 4; ++m)
#pragma unroll
                for (int n = 0; n < 2; ++n) acc[a][b][m][n] = (f32x4){0.f, 0.f, 0.f, 0.f};
    bf16x8 At[4][2], B0[2][2], B1[2][2];
    const char* cA = (const char*)g.A + (size_t)cur.pm * tstep; const char* cB = (const char*)g.Bt + (size_t)cur.pn * tstep;
    S.a_ready(cur);
    if constexpr (SP2) {
        PG8_STAGE(PG8_SB(0, 0), cB, voffB); PG8_STAGE(PG8_SB(0, 1), cB + hstep, voffB); PG8_STAGE(PG8_SA(0, 0), cA, voffA); PG8_STAGE(PG8_SA(0, 1), cA + hstep, voffA);
        if (wr == 1) PG8_BAR;
        PG8_WAIT_V(2); PG8_BAR;
        PG8_STAGE(PG8_SB(1, 0), cB + kstep, voffB); PG8_STAGE(PG8_SA(1, 0), cA + kstep, voffA); PG8_STAGE(PG8_SB(1, 1), cB + hstep + kstep, voffB);
        PG8_WAIT_V(6); PG8_BAR;
    } else {
        PG8_STAGE(PG8_SB(0, 0), cB, voffB); PG8_STAGE(PG8_SA(0, 0), cA, voffA); PG8_STAGE(PG8_SB(0, 1), cB + hstep, voffB); PG8_STAGE(PG8_SA(0, 1), cA + hstep, voffA);
        if (wr == 1) PG8_BAR;
        PG8_WAIT_V(4); PG8_BAR;
        PG8_STAGE(PG8_SB(1, 0), cB + kstep, voffB); PG8_STAGE(PG8_SA(1, 0), cA + kstep, voffA); PG8_STAGE(PG8_SB(1, 1), cB + hstep + kstep, voffB);
        PG8_WAIT_V(6); PG8_BAR;
    }
    for (;;) {
        const bool has_next = S.next(ui + 1, nxt);
        const char* nA = has_next ? (const char*)g.A + (size_t)nxt.pm * tstep : cA; const char* nB = has_next ? (const char*)g.Bt + (size_t)nxt.pn * tstep : cB;
        for (int t = 0; t < nt; t += 2) {
            if constexpr (Epi::HAS_MID) { if (t == Epi::MID_T) E.mid(acc, cur, wr, wc, fr, fq); }
            const bool last = (t == nt - 2);
            const char* a1 = cA + (size_t)(t + 1) * kstep;
            const char* a2 = last ? nA : cA + (size_t)(t + 2) * kstep; const char* b2 = last ? nB : cB + (size_t)(t + 2) * kstep;
            const char* a3 = a2 + kstep; const char* b3 = b2 + kstep;
            if (last && has_next) S.a_ready(nxt);
            if constexpr (SP2) {
            PG8_LDB(B0, 0, 0); PG8_LDB(B1, 0, 1); PG8_SCHED; PG8_LDA(At, 0, 0); PG8_STAGE(PG8_SA(1, 1), a1 + hstep, voffA);
            PG8_WAIT_V(8); PG8_WAIT_L(0); PG8_BAR; PG8_MMA(0, 0, At, B0); PG8_MMA(0, 1, At, B1); PG8_BAR; PG8_SCHED;
            PG8_LDA(At, 0, 1); PG8_STAGE(PG8_SB(0, 0), b2, voffB); PG8_STAGE(PG8_SB(0, 1), b2 + hstep, voffB); PG8_STAGE(PG8_SA(0, 0), a2, voffA);
            PG8_WAIT_V(8); PG8_WAIT_L(0); PG8_BAR; PG8_MMA(1, 0, At, B0); PG8_MMA(1, 1, At, B1); PG8_BAR; PG8_SCHED;
            PG8_LDB(B0, 1, 0); PG8_LDB(B1, 1, 1); PG8_SCHED; PG8_LDA(At, 1, 0); PG8_STAGE(PG8_SA(0, 1), a2 + hstep, voffA);
            PG8_WAIT_V(8); PG8_WAIT_L(0); PG8_BAR; PG8_MMA(0, 0, At, B0); PG8_MMA(0, 1, At, B1); PG8_BAR; PG8_SCHED;
            PG8_LDA(At, 1, 1); PG8_STAGE(PG8_SB(1, 0), b3, voffB); PG8_STAGE(PG8_SB(1, 1), b3 + hstep, voffB); PG8_STAGE(PG8_SA(1, 0), a3, voffA);
            PG8_WAIT_V(8); PG8_WAIT_L(0); PG8_BAR; PG8_MMA(1, 0, At, B0); PG8_MMA(1, 1, At, B1); PG8_BAR; PG8_SCHED;
            } else {
            PG8_LDB(B0, 0, 0); PG8_SCHED; PG8_LDA(At, 0, 0); PG8_STAGE(PG8_SA(1, 1), a1 + hstep, voffA);
            PG8_WAIT_L(8); PG8_BAR; PG8_WAIT_L(0); PG8_MMA(0, 0, At, B0); PG8_BAR; PG8_SCHED;
            PG8_LDB(B1, 0, 1); PG8_STAGE(PG8_SB(0, 0), b2, voffB);
            PG8_BAR; PG8_WAIT_L(0); PG8_MMA(0, 1, At, B1); PG8_BAR;
            PG8_LDA(At, 0, 1); PG8_STAGE(PG8_SA(0, 0), a2, voffA);
            PG8_BAR; PG8_WAIT_L(0); PG8_MMA(1, 0, At, B0); PG8_BAR; PG8_SCHED;
            PG8_STAGE(PG8_SB(0, 1), b2 + hstep, voffB);
            PG8_WAIT_V(6); PG8_BAR; PG8_MMA(1, 1, At, B1); PG8_BAR;
            PG8_LDB(B0, 1, 0); PG8_SCHED; PG8_LDA(At, 1, 0); PG8_STAGE(PG8_SA(0, 1), a2 + hstep, voffA);
            PG8_WAIT_L(8); PG8_BAR; PG8_WAIT_L(0); PG8_MMA(0, 0, At, B0); PG8_BAR; PG8_SCHED;
            PG8_LDB(B1, 1, 1); PG8_STAGE(PG8_SB(1, 0), b3, voffB);
            PG8_BAR; PG8_WAIT_L(0); PG8_MMA(0, 1, At, B1); PG8_BAR;
            PG8_LDA(At, 1, 1); PG8_STAGE(PG8_SA(1, 0), a3, voffA);
            PG8_BAR; PG8_WAIT_L(0); PG8_MMA(1, 0, At, B0); PG8_BAR; PG8_SCHED;
            PG8_STAGE(PG8_SB(1, 1), b3 + hstep, voffB);
            PG8_WAIT_V(6); PG8_BAR; PG8_MMA(1, 1, At, B1); PG8_BAR;
            }
        }
        if constexpr (ALIGN_EPI) { if (wr == 0) PG8_BAR; }
        if constexpr (!Epi::AFTER_DRAIN) { E(acc, cur, wr, wc, fr, fq); S.done(cur); }
        if (!has_next) break;
#pragma unroll
        for (int a = 0; a < 2; ++a)
#pragma unroll
            for (int b = 0; b < 2; ++b)
#pragma unroll
                for (int m = 0; m < 4; ++m)
#pragma unroll
                    for (int n = 0; n < 2; ++n) acc[a][b][m][n] = (f32x4){0.f, 0.f, 0.f, 0.f};
        cur = nxt; cA = nA; cB = nB; ++ui;
        if constexpr (ALIGN_EPI) { if (wr == 1) PG8_BAR; }
    }
    PG8_WAIT_V(0);
    if constexpr (!ALIGN_EPI) { if (wr == 0) PG8_BAR; }
    PG8_BAR;
    if constexpr (Epi::AFTER_DRAIN) { E.fused(acc, cur, wr, wc, fr, fq, lds, wid, lane); S.done(cur); }
#undef PG8_SA
#undef PG8_SB
#undef PG8_STAGE
#undef PG8_LDA
#undef PG8_LDB
#undef PG8_MMA
#undef PG8_WAIT_V
#undef PG8_WAIT_L
#undef PG8_BAR
#undef PG8_SCHED
}
}

namespace fa {
typedef unsigned short bf16;
typedef short bf16x8 __attribute__((ext_vector_type(8)));
typedef short s16x4 __attribute__((ext_vector_type(4)));
typedef float f32x16 __attribute__((ext_vector_type(16)));
typedef float f32x4 __attribute__((ext_vector_type(4)));
typedef unsigned u32x4 __attribute__((ext_vector_type(4)));
constexpr int D = 128, QP = 2048, KP = 1024, ZP = 1024, SEQ = 4096;
constexpr float SCALE = 0.08838834764831845f, INV_SCALE = 11.313708498984761f;
constexpr float THR = 8.f;
constexpr int NW = 8, QBLK = 32, KVBLK = 64, QB = NW * QBLK;
constexpr int SHM_V = KVBLK * D * 2, SHM_K = KVBLK * D * 2;
constexpr int LDS_WS_OFF = 2 * SHM_V + 2 * SHM_K;
constexpr int LDS_CB_OFF = LDS_WS_OFF + NW * 64 * 4;
constexpr int CB_BYTES = SEQ * 8;
constexpr int LDS_STG_OFF = LDS_CB_OFF + CB_BYTES;
constexpr int LDS_BYTES = LDS_STG_OFF + NW * 4352;

#define KSWZ(row, colB) ((row) * 256 + ((colB) ^ (((row) & 7) << 4)))
#define SBAR() __builtin_amdgcn_sched_barrier(0)
__device__ __forceinline__ int v_st(int k, int c) { const int kk = (k & ~0xC) | ((k & 4) << 1) | ((k & 8) >> 1); return ((kk >> 3) * 4 + (c >> 5)) * 512 + ((kk & 7) * 32 + (c & 31)) * 2; }
__device__ __forceinline__ int v_rd_base(int lane) { return ((lane & 3) << 3) | (((lane >> 2) & 3) << 6) | (((lane >> 4) & 1) << 5) | (((lane >> 5) & 1) << 8); }
constexpr int v_rd_off(int d0, int ks, int half) { return d0 * 512 + ks * 4096 + half * 2048; }
__device__ __forceinline__ int crow(int r, int hi) { return (r & 3) + 8 * (r >> 2) + 4 * hi; }
__device__ __forceinline__ unsigned cvtpk(float lo, float hi) { unsigned r; asm volatile("v_cvt_pk_bf16_f32 %0, %1, %2" : "=v"(r) : "v"(lo), "v"(hi)); return r; }
__device__ __forceinline__ bf16x8 load8(const bf16* p) { return *reinterpret_cast<const bf16x8*>(p); }
__device__ __forceinline__ void mask_tile(f32x16& p0, f32x16& p1, int dq, unsigned W) {
    const float NEG = -__builtin_inff();
#pragma unroll
    for (int r = 0; r < 16; ++r) {
        const int c = (r & 3) + 8 * (r >> 2);
        if ((unsigned)(dq - c) >= W) p0[r] = NEG;
        if ((unsigned)(dq - c - 32) >= W) p1[r] = NEG;
    }
}
__device__ __forceinline__ void partialSM(f32x16& p0, f32x16& p1, float& m_reg, float& mn, float& alpha) {
    float pmax = p0[0]; for (int r = 1; r < 16; ++r) pmax = fmaxf(pmax, p0[r]); for (int r = 0; r < 16; ++r) pmax = fmaxf(pmax, p1[r]);
    { auto rr = __builtin_amdgcn_permlane32_swap(__float_as_uint(pmax), __float_as_uint(pmax), false, false);
      pmax = fmaxf(__uint_as_float(rr[0]), __uint_as_float(rr[1])); }
    constexpr float C2 = 1.4426950408889634f * SCALE;
    if (__builtin_expect(__all((pmax - m_reg) * SCALE <= THR), 1)) { mn = m_reg; alpha = 1.f; }
    else { mn = fmaxf(m_reg, pmax); alpha = __builtin_amdgcn_exp2f((m_reg - mn) * C2); m_reg = mn; }
    const float mnL = -mn * C2;
    for (int r = 0; r < 16; ++r) p0[r] = fmaf(p0[r], C2, mnL); for (int r = 0; r < 16; ++r) p1[r] = fmaf(p1[r], C2, mnL);
    for (int r = 0; r < 16; ++r) p0[r] = __builtin_amdgcn_exp2f(p0[r]);
}
__device__ __forceinline__ void finishSM(f32x16& p0, f32x16& p1, float alpha, float& l_reg, bf16x8& pa0, bf16x8& pa1, bf16x8& pa2, bf16x8& pa3) {
    for (int r = 0; r < 16; ++r) p1[r] = __builtin_amdgcn_exp2f(p1[r]);
    float ps = 0; for (int r = 0; r < 16; ++r) ps += p0[r]; for (int r = 0; r < 16; ++r) ps += p1[r];
    { auto rr = __builtin_amdgcn_permlane32_swap(__float_as_uint(ps), __float_as_uint(ps), false, false);
      ps = __uint_as_float(rr[0]) + __uint_as_float(rr[1]); }
    l_reg = l_reg * alpha + ps;
#define PK4(P, B_, OUT) do { unsigned a0 = cvtpk(P[B_+0], P[B_+1]), a1 = cvtpk(P[B_+2], P[B_+3]);                          \
        unsigned b0 = cvtpk(P[B_+4], P[B_+5]), b1 = cvtpk(P[B_+6], P[B_+7]);                                             \
        auto r0 = __builtin_amdgcn_permlane32_swap(a0, b0, false, false); auto r1 = __builtin_amdgcn_permlane32_swap(a1, b1, false, false); \
        u32x4 w = {r0[0], r1[0], r0[1], r1[1]}; OUT = *reinterpret_cast<bf16x8*>(&w); } while (0)
    PK4(p0, 0, pa0); PK4(p0, 8, pa1); PK4(p1, 0, pa2); PK4(p1, 8, pa3);
#undef PK4
}
typedef unsigned u32x2 __attribute__((ext_vector_type(2)));
template <int KB>
__device__ __forceinline__ void qkt(f32x16& p0, f32x16& p1, const char* K_lds, const char* cbt, int r32, int hi, const bf16x8* qr) {
    { const u32x2 e0 = *(const u32x2*)(cbt), e1 = *(const u32x2*)(cbt + 32 * 8);
      const unsigned c0 = hi ? 0u : 0x3F803F80u, c1 = hi ? 0u : 0x00003F80u;
      const u32x4 k0 = {e0.x, e0.y, e0.x, e0.y}, k1 = {e1.x, e1.y, e1.x, e1.y}, q1 = {c0, c1, 0u, 0u};
      p0 = __builtin_amdgcn_mfma_f32_32x32x16_bf16(__builtin_bit_cast(bf16x8, k0), __builtin_bit_cast(bf16x8, q1), f32x16{}, 0, 0, 0);
      p1 = __builtin_amdgcn_mfma_f32_32x32x16_bf16(__builtin_bit_cast(bf16x8, k1), __builtin_bit_cast(bf16x8, q1), f32x16{}, 0, 0, 0); }
    const char* kb[4];
#pragma unroll
    for (int dd = 0; dd < 4; ++dd) kb[dd] = K_lds + KB * SHM_K + KSWZ(r32, (dd * 16 + hi * 8) * 2);
#pragma unroll
    for (int d0 = 0; d0 < 8; ++d0) { const char* a = kb[d0 & 3] + (d0 >> 2) * 128;
        bf16x8 b0 = *reinterpret_cast<const bf16x8*>(a);
        bf16x8 b1 = *reinterpret_cast<const bf16x8*>(a + 32 * 256);
        p0 = __builtin_amdgcn_mfma_f32_32x32x16_bf16(b0, qr[d0], p0, 0, 0, 0);
        p1 = __builtin_amdgcn_mfma_f32_32x32x16_bf16(b1, qr[d0], p1, 0, 0, 0); }
}
template <int VB>
__device__ __forceinline__ void pv_tile(f32x16* o, int vb0, bf16x8 pa0, bf16x8 pa1, bf16x8 pa2, bf16x8 pa3) {
#define TRRD(dst, off) asm volatile("ds_read_b64_tr_b16 %0, %1 offset:%2" : "=&v"(dst) : "v"(vb0), "i"(off) : "memory")
#define VF(l, h) (bf16x8){l[0], l[1], l[2], l[3], h[0], h[1], h[2], h[3]}
#define PV_R(d0, ks, PA, PB) do { s16x4 l0, h0, l1, h1, m0, n0, m1, n1;                                                                \
        constexpr int b_ = VB * SHM_V + v_rd_off(d0, ks, 0), c_ = VB * SHM_V + v_rd_off(d0 + 1, ks, 0);                               \
        TRRD(l0, b_); TRRD(h0, b_ + 2048); TRRD(m0, c_); TRRD(n0, c_ + 2048); TRRD(l1, b_ + 4096); TRRD(h1, b_ + 6144); TRRD(m1, c_ + 4096); TRRD(n1, c_ + 6144); \
        asm volatile("s_waitcnt lgkmcnt(0)" ::: "memory"); SBAR();                                                                   \
        o[d0]     = __builtin_amdgcn_mfma_f32_32x32x16_bf16(PA, VF(l0, h0), o[d0], 0, 0, 0);                                          \
        o[d0 + 1] = __builtin_amdgcn_mfma_f32_32x32x16_bf16(PA, VF(m0, n0), o[d0 + 1], 0, 0, 0);                                      \
        o[d0]     = __builtin_amdgcn_mfma_f32_32x32x16_bf16(PB, VF(l1, h1), o[d0], 0, 0, 0);                                          \
        o[d0 + 1] = __builtin_amdgcn_mfma_f32_32x32x16_bf16(PB, VF(m1, n1), o[d0 + 1], 0, 0, 0); } while (0)
    PV_R(0, 0, pa0, pa1); PV_R(0, 2, pa2, pa3); PV_R(2, 0, pa0, pa1); PV_R(2, 2, pa2, pa3);
#undef PV_R
#undef VF
#undef TRRD
}

struct BlockRef { const bf16* Q; const bf16* K; const bf16* V; bf16* O; const bf16* Z; const float* C; int P0; };
struct Seam { bf16x8 qr[8]; bf16x8 st_v0, st_v1, st_k0, st_k1; };
__device__ __forceinline__ void fill_cb(const float* C, int P0, char* cb) {
    const int n = P0 + QB; const float ref = C[P0];
    for (int i = threadIdx.x * 4; i < n; i += 2048) { const f32x4 c = *(const f32x4*)(C + i); u32x4 o0, o1;
#pragma unroll
        for (int j = 0; j < 4; ++j) { const float x = (ref - c[j]) * INV_SCALE; const unsigned u1 = __float_as_uint(x) & 0xffff0000u; const float r1 = x - __uint_as_float(u1);
            const unsigned u2 = __float_as_uint(r1) & 0xffff0000u; const float r2 = r1 - __uint_as_float(u2); const unsigned u3 = cvtpk(r2, 0.f) & 0xffffu;
            const unsigned w0 = (u1 >> 16) | u2, w1 = u3;
            if (j < 2) { o0[2 * j] = w0; o0[2 * j + 1] = w1; } else { o1[2 * (j - 2)] = w0; o1[2 * (j - 2) + 1] = w1; } }
        *(u32x4*)(cb + (size_t)i * 8) = o0; *(u32x4*)(cb + (size_t)i * 8 + 16) = o1; }
}
#define ROWK(p, k0, rr) ((p) + (size_t)((k0) + (rr)) * KP + sc)
#define VMW() asm volatile("s_waitcnt vmcnt(0)" ::: "memory")
#define VMWN(n) asm volatile("s_waitcnt vmcnt(%0)" :: "i"(n) : "memory")
#define SLOAD_H(Kp, Vp, k0) do { S.st_v0 = load8(ROWK(Vp, k0, sr)); S.st_v1 = load8(ROWK(Vp, k0, 32 + sr));              \
                         S.st_k0 = load8(ROWK(Kp, k0, sr)); S.st_k1 = load8(ROWK(Kp, k0, 32 + sr)); } while (0)
#define OPQ_TID() int t_ = threadIdx.x; asm volatile("" : "+v"(t_)); const int sr_ = t_ >> 4, sc_ = (t_ & 15) * 8
#define SWRITE_HK(bf) do { OPQ_TID(); const int kws_ = KSWZ(sr_, sc_ * 2); *(bf16x8*)(K_lds + (bf) * SHM_K + kws_) = S.st_k0; *(bf16x8*)(K_lds + (bf) * SHM_K + kws_ + 32 * 256) = S.st_k1; } while (0)
#define SWRITE_HV(bf) do { OPQ_TID(); const int vst0_ = v_st(sr_, sc_), vst1_ = v_st(32 + sr_, sc_); *(bf16x8*)(V_lds + (bf) * SHM_V + vst0_) = S.st_v0; *(bf16x8*)(V_lds + (bf) * SHM_V + vst1_) = S.st_v1; } while (0)
#define SWRITE_H(bf) do { SWRITE_HV(bf); SWRITE_HK(bf); } while (0)
__device__ __forceinline__ void fox_prime(const BlockRef& cur, char* lds, char* cbcur, Seam& S) {
    const int tid = threadIdx.x, wid = __builtin_amdgcn_readfirstlane(tid >> 6), lane = tid & 63, r32 = lane & 31, hi = lane >> 5;
    const int sr = tid >> 4, sc = (tid & 15) * 8; char* K_lds = lds + 2 * SHM_V;
    for (int d0 = 0; d0 < 8; ++d0) S.qr[d0] = load8(cur.Q + (size_t)(wid * QBLK + r32) * QP + d0 * 16 + hi * 8);
    SLOAD_H(cur.K, cur.V, cur.P0 + QB - KVBLK); VMW(); SWRITE_HK(0);
    fill_cb(cur.C, cur.P0, cbcur);
    __syncthreads();
}
__device__ __forceinline__ void fox_block(const BlockRef& cur, const BlockRef& nxt, char* lds, char* cbcur, char* cbnxt, Seam& S) {
    const int tid = threadIdx.x, wid = __builtin_amdgcn_readfirstlane(tid >> 6), lane = tid & 63, r32 = lane & 31, hi = lane >> 5;
    const int W = 1 << 30;
    const int NT = (cur.P0 + QB) / KVBLK;
    const int qlo = cur.P0 + wid * QBLK, qm = qlo + r32 - 4 * hi;
    char* V_lds = lds; char* K_lds = lds + 2 * SHM_V;
    float* ws = (float*)(lds + LDS_WS_OFF) + wid * 64; float* li_l = ws, * al_l = ws + 32;
    float m_reg = -1e30f, l_reg = 0; f32x16 o[4] = {};
    const int sr = tid >> 4, sc = (tid & 15) * 8;
    const int vb0 = (int)(uintptr_t)V_lds + v_rd_base(lane);
    const bf16* Kh = cur.K; const bf16* Vh = cur.V;
    const char* cbl = cbcur + 8 * r32;
#define RESC(a) do { if (__any((a) < 1.f)) { if (hi == 0) al_l[r32] = (a); asm volatile("s_waitcnt lgkmcnt(0)" ::: "memory");              \
                     for (int d_ = 0; d_ < 4; ++d_) for (int r = 0; r < 16; ++r) o[d_][r] *= al_l[crow(r, hi)]; } } while (0)
#define KBASE(t) ((NT - 1 - (t)) * KVBLK)
#define MASKT(P0_, P1_, t) do { const int kb_ = KBASE(t); if (kb_ + KVBLK - 1 > qlo) mask_tile(P0_, P1_, qm - kb_, (unsigned)W); } while (0)
    constexpr int NQL = 8;
#define SEAM_K0() do { VMWN(NQL); SWRITE_HK(0); SBAR(); } while (0)
    f32x16 pA0, pA1, pB0, pB1; float mnA, mnB, alA, alB; bf16x8 pa0, pa1, pa2, pa3;
    SWRITE_HV(0); SBAR();
    if (NT > 1) { SLOAD_H(Kh, Vh, KBASE(1)); }
    SBAR(); qkt<0>(pA0, pA1, K_lds, cbl + 8 * KBASE(0), r32, hi, S.qr);
    MASKT(pA0, pA1, 0); partialSM(pA0, pA1, m_reg, mnA, alA);
    if (NT > 1) { VMW(); SWRITE_H(1); }
    __syncthreads();
#define HALF_STEP(PX0, PX1, mnX, alX, PY0, PY1, alY, t, KB, VB, SB) do {                                                      \
        SBAR(); if ((t) + 1 < NT) { SLOAD_H(Kh, Vh, KBASE((t) + 1)); SBAR(); }     \
        qkt<KB>(PX0, PX1, K_lds, cbl + 8 * KBASE(t), r32, hi, S.qr);                                             \
        finishSM(PY0, PY1, alY, l_reg, pa0, pa1, pa2, pa3); SBAR();                                                           \
        pv_tile<VB>(o, vb0, pa0, pa1, pa2, pa3); MASKT(PX0, PX1, (t)); partialSM(PX0, PX1, m_reg, mnX, alX);                                        \
        __syncthreads();                                                                                                      \
        if ((t) + 1 < NT) { VMW(); SWRITE_H(SB); }                                                                          \
        RESC(alX); __syncthreads(); } while (0)
    for (int t = 1; t + 1 < NT; t += 2) {
        HALF_STEP(pB0, pB1, mnB, alB, pA0, pA1, alA, t, 1, 0, 0);
        HALF_STEP(pA0, pA1, mnA, alA, pB0, pB1, alB, t + 1, 0, 1, 1);
    }
    const bool even = (NT & 1) == 0;
    if (even) { SBAR(); qkt<1>(pB0, pB1, K_lds, cbl + 8 * KBASE(NT - 1), r32, hi, S.qr); SBAR(); }
    SLOAD_H(nxt.K, nxt.V, nxt.P0 + QB - KVBLK); SBAR();
#pragma unroll
    for (int d0 = 0; d0 < 8; ++d0) S.qr[d0] = load8(nxt.Q + (size_t)(wid * QBLK + r32) * QP + d0 * 16 + hi * 8);
    SBAR();
    finishSM(pA0, pA1, alA, l_reg, pa0, pa1, pa2, pa3); SBAR();
    pv_tile<0>(o, vb0, pa0, pa1, pa2, pa3);
    if (even) { MASKT(pB0, pB1, NT - 1); partialSM(pB0, pB1, m_reg, mnB, alB); __syncthreads(); RESC(alB);
        finishSM(pB0, pB1, alB, l_reg, pa0, pa1, pa2, pa3); SBAR(); pv_tile<1>(o, vb0, pa0, pa1, pa2, pa3); }
    SBAR(); SEAM_K0();
    if (hi == 0) li_l[r32] = l_reg; asm volatile("s_waitcnt lgkmcnt(0)" ::: "memory");
    float rli[16];
#pragma unroll
    for (int r = 0; r < 16; ++r) rli[r] = __builtin_amdgcn_rcpf(li_l[crow(r, hi)]);
    {
        int ln = lane; asm volatile("" : "+v"(ln)); const int r32e = ln & 31, hie = ln >> 5;
        char* stg = lds + LDS_STG_OFF + wid * 4352;
        bf16* Ow = cur.O + (size_t)(wid * QBLK) * QP; const bf16* Zw = cur.Z + (size_t)(wid * QBLK) * ZP;
#pragma unroll
        for (int half = 0; half < 2; ++half) {
#pragma unroll
            for (int rr = 0; rr < 8; ++rr) { const int r = half * 8 + rr; const int lrow = (rr & 3) + 8 * (rr >> 2) + 4 * hie;
#pragma unroll
                for (int d0 = 0; d0 < 4; ++d0) *(unsigned short*)(stg + lrow * 272 + (d0 * 32 + r32e) * 2) = (unsigned short)cvtpk(o[d0][r] * rli[r], 0.f); }
            asm volatile("s_waitcnt lgkmcnt(0)" ::: "memory");
#pragma unroll
            for (int it = 0; it < 4; ++it) { const int lrow = it * 4 + (ln >> 4), ch = ln & 15, grow = half * 16 + lrow;
                const u32x4 ov = *(const u32x4*)(stg + lrow * 272 + ch * 16); const u32x4 z = *(const u32x4*)(Zw + (size_t)grow * ZP + ch * 8);
                u32x4 w;
                w.x = cvtpk(__uint_as_float(ov.x << 16) * __uint_as_float(z.x << 16), __uint_as_float(ov.x & 0xffff0000u) * __uint_as_float(z.x & 0xffff0000u));
                w.y = cvtpk(__uint_as_float(ov.y << 16) * __uint_as_float(z.y << 16), __uint_as_float(ov.y & 0xffff0000u) * __uint_as_float(z.y & 0xffff0000u));
                w.z = cvtpk(__uint_as_float(ov.z << 16) * __uint_as_float(z.z << 16), __uint_as_float(ov.z & 0xffff0000u) * __uint_as_float(z.z & 0xffff0000u));
                w.w = cvtpk(__uint_as_float(ov.w << 16) * __uint_as_float(z.w << 16), __uint_as_float(ov.w & 0xffff0000u) * __uint_as_float(z.w & 0xffff0000u));
                *(u32x4*)(Ow + (size_t)grow * QP + ch * 8) = w; }
            asm volatile("s_waitcnt lgkmcnt(0)" ::: "memory");
        }
    }
    fill_cb(nxt.C, nxt.P0, cbnxt);
    __syncthreads();
#undef RESC
#undef KBASE
#undef MASKT
#undef SEAM_K0
#undef HALF_STEP
}
#undef ROWK
#undef VMW
#undef VMWN
#undef SLOAD_H
#undef SWRITE_HK
#undef SWRITE_HV
#undef SWRITE_H
#undef OPQ_TID
#undef KSWZ
#undef SBAR

struct Tensors { const bf16* AO; const bf16* K; const bf16* V; const bf16* ZB; const float* C; };
__device__ __forceinline__ BlockRef make_ref(const Tensors& T, int bh, int qb) {
    const int b = bh >> 3, h = bh & 7; const size_t row0 = (size_t)b * SEQ + (size_t)qb * QB;
    BlockRef r;
    r.Q = T.AO + row0 * QP + 1024 + h * D; r.O = (bf16*)r.Q;
    r.K = T.K + (size_t)b * SEQ * KP + h * D; r.V = T.V + (size_t)b * SEQ * KP + h * D;
    r.Z = T.ZB + row0 * ZP + h * D; r.C = T.C + (size_t)bh * SEQ; r.P0 = qb * QB;
    return r;
}
__device__ __forceinline__ void fox_phase(char* lds, const Tensors& T, int vcu, int G) {
    constexpr int total = 64 * 8;
    int L = vcu; if (L >= total) return;
    int pass = 0, par = 0;
    char* cb0 = lds + LDS_CB_OFF;
    BlockRef cur = make_ref(T, L >> 3, L & 7);
    Seam S;
    fox_prime(cur, lds, cb0, S);
    for (;;) {
        const bool more_pass = pass == 0, more_item = L + G < total, last = !more_pass && !more_item;
        int passn = pass + 1, Ln = L;
        if (!more_pass) { passn = 0; Ln = more_item ? L + G : L; }
        const int qbn = passn ? 15 - (Ln & 7) : (Ln & 7);
        const BlockRef nxt = last ? cur : make_ref(T, Ln >> 3, qbn);
        fox_block(cur, nxt, lds, cb0, cb0, S);
        if (last) break;
        cur = nxt; pass = passn; L = Ln; par ^= 1;
    }
}
}

#ifndef MK_N_LAUNCHES
#define MK_N_LAUNCHES 1
#endif
constexpr int N_LAUNCHES = MK_N_LAUNCHES;
constexpr int N_PHASES = 7;
constexpr int NWAVES = 8;
constexpr int BATCH = 8, SEQ = 4096, DM = 1024, T = BATCH * SEQ, NIN = 9224, NH = 8;
constexpr int NP1 = 7168, NG = 2048;
constexpr float EPS = 1e-6f;
constexpr size_t MiB = 1u << 20;
constexpr size_t WS_SSQ = 0, WS_LOGF = 1 * MiB, WS_CC = 2 * MiB, WS_WSM = 3 * MiB;
constexpr size_t WS_W1 = 4 * MiB, WS_WG = 18 * MiB, WS_WAB = 22 * MiB, WS_WO = 26 * MiB;
constexpr size_t WS_AO = 32 * MiB, WS_VA = 160 * MiB, WS_ZA = 224 * MiB, WS_K = 288 * MiB, WS_V = 352 * MiB, WS_ZB = 416 * MiB, WS_END = 480 * MiB;
constexpr int RING_BYTES = 131072, LDS_BYTES = 147456;
static_assert(fa::LDS_BYTES <= LDS_BYTES, "attention LDS");

#define GAS __attribute__((address_space(1)))
#define LAS __attribute__((address_space(3)))
typedef unsigned short bf16;
typedef unsigned v4u __attribute__((ext_vector_type(4)));
typedef float f32x4 __attribute__((ext_vector_type(4)));
typedef short bf16x8 __attribute__((ext_vector_type(8)));
#define LDS_WAIT() asm volatile("s_waitcnt lgkmcnt(0)" ::: "memory")
__device__ __forceinline__ unsigned f2bf(float f) { unsigned u = __builtin_bit_cast(unsigned, f); return (u + 0x7fffu + ((u >> 16) & 1u)) >> 16; }
__device__ __forceinline__ unsigned pk2(float lo, float hi) { return pg8::cvt_pk_bf16_c(lo, hi); }
__device__ __forceinline__ float wave_sum(float v) {
#pragma unroll
    for (int o = 1; o < 64; o <<= 1) v += __shfl_xor(v, o);
    return v;
}
__device__ __forceinline__ void transpose_item(const float* W, int ldw, int nblk, bf16* WT, int ldt, LAS float* scr, int item, int lane) {
    const int kb = item / nblk, nb = item % nblk, k0 = 64 * kb, n0 = 32 * nb;
#pragma unroll 8
    for (int i = 0; i < 32; ++i) { const int kk = 2 * i + (lane >> 5); scr[kk * 33 + (lane & 31)] = W[(size_t)(k0 + kk) * ldw + n0 + (lane & 31)]; }
    LDS_WAIT(); asm volatile("" ::: "memory");
    const int c = lane & 7;
#pragma unroll
    for (int j = 0; j < 4; ++j) { const int n = (lane >> 3) + 8 * j; const LAS float* s = scr + (8 * c) * 33 + n;
        v4u o; o.x = pk2(s[0 * 33], s[1 * 33]); o.y = pk2(s[2 * 33], s[3 * 33]); o.z = pk2(s[4 * 33], s[5 * 33]); o.w = pk2(s[6 * 33], s[7 * 33]);
        *(GAS v4u*)(WT + (size_t)(n0 + n) * ldt + k0 + 8 * c) = o; }
    LDS_WAIT(); asm volatile("" ::: "memory");
}

#define XB_TMO      128
#define XB_XCNT(j)  (256  + 64 * (j))
#define XB_XSUB(j)  (1280 + 64 * (j))
#define XB_XGEN(j)  (2304 + 64 * (j))
#define XB_TOP      3328
#define XB_TOPGEN   3392
#define XCD_BAR_WORDS 3456
#define XB_SPIN_CAP (1u << 18)

__device__ __forceinline__ unsigned xb_ld(unsigned* p)              { return __hip_atomic_load(p, __ATOMIC_RELAXED, __HIP_MEMORY_SCOPE_AGENT); }
__device__ __forceinline__ unsigned xb_add(unsigned* p, unsigned v) { return __hip_atomic_fetch_add(p, v, __ATOMIC_RELAXED, __HIP_MEMORY_SCOPE_AGENT); }
__device__ __forceinline__ unsigned xb_xcc_id() { return (unsigned)__builtin_amdgcn_s_getreg((3 << 11) | 20) & 0xFu; }
#define XB_SPIN(cond, bar) do { unsigned _sp = 0; while (cond) { __builtin_amdgcn_s_sleep(1); \
    if ((++_sp & 255u) == 0u) { if (xb_ld(&(bar)[XB_TMO])) break; if (_sp > XB_SPIN_CAP) { atomicAdd(&(bar)[XB_TMO], 1u); break; } } } } while (0)

struct XcdBarrier {
    unsigned* bar; unsigned x;
    volatile LAS unsigned* st;
};

__device__ __forceinline__ XcdBarrier xcd_barrier_post(unsigned* bar, volatile LAS unsigned* st) {
    XcdBarrier b; b.bar = bar; b.x = xb_xcc_id(); b.st = st;
    if (threadIdx.x == 0) (void)xb_add(&bar[XB_XCNT(b.x)], 1u);
    return b;
}
__device__ __forceinline__ void xcd_barrier_complete(unsigned* bar, unsigned x, unsigned& nloc, unsigned& nx) {
    const unsigned G = gridDim.x * gridDim.y * gridDim.z;
    unsigned sum, cnt, mine, sp = 0u;
    for (;;) {
        sum = 0u; cnt = 0u; mine = 0u;
#pragma unroll
        for (unsigned j = 0; j < 16; ++j) { const unsigned c = xb_ld(&bar[XB_XCNT(j)]); sum += c; cnt += (c > 0u) ? 1u : 0u; mine = (j == x) ? c : mine; }
        if (sum == G) break;
        __builtin_amdgcn_s_sleep(1);
        if ((++sp & 255u) == 0u) { if (xb_ld(&bar[XB_TMO])) break; if (sp > XB_SPIN_CAP) { atomicAdd(&bar[XB_TMO], 1u); break; } }
    }
    nloc = mine > 0u ? mine : 1u; nx = cnt > 0u ? cnt : 1u;
}

__device__ __forceinline__ void xcd_barrier(const XcdBarrier& b) {
    asm volatile("s_waitcnt vmcnt(0)" ::: "memory");
    __syncthreads();
    if (threadIdx.x == 0) {
        unsigned* bar = b.bar;
        __builtin_amdgcn_s_waitcnt(0);
        unsigned nloc = b.st[0], nx = b.st[1];
        if (nloc == 0u) { xcd_barrier_complete(bar, b.x, nloc, nx); b.st[0] = nloc; b.st[1] = nx; }
        const unsigned old = xb_add(&bar[XB_XSUB(b.x)], 1u);
        const unsigned gen = old / nloc;
        if (old + 1u == (gen + 1u) * nloc) {
            __builtin_amdgcn_fence(__ATOMIC_RELEASE, "agent");
            asm volatile("s_waitcnt vmcnt(0)" ::: "memory");
            const unsigned og = xb_add(&bar[XB_TOP], 1u);
            const unsigned tg = og / nx;
            if (og + 1u == (tg + 1u) * nx) xb_add(&bar[XB_TOPGEN], 1u);
            else XB_SPIN(xb_ld(&bar[XB_TOPGEN]) == tg, bar);
            __builtin_amdgcn_fence(__ATOMIC_ACQUIRE, "agent");
            xb_add(&bar[XB_XGEN(b.x)], 1u);
            asm volatile("s_waitcnt vmcnt(0)" ::: "memory");
        } else {
            XB_SPIN(xb_ld(&bar[XB_XGEN(b.x)]) == gen, bar);
            __builtin_amdgcn_fence(__ATOMIC_ACQUIRE, "agent");
            asm volatile("s_waitcnt vmcnt(0)" ::: "memory");
        }
    }
    __syncthreads();
}

constexpr size_t WS_BAR = 512 * 1024, WS_CNT = WS_BAR + 16384; constexpr int BAR_BYTES = 16384 + 128 * 256, MISC_OFF = 147200;
static_assert(XCD_BAR_WORDS * 4 <= 16384 && fa::LDS_BYTES <= MISC_OFF, "barrier words / LDS map");
struct Args { const float* in[13]; float* out; unsigned char* ws; int ph_lo, ph_hi; };

__device__ __forceinline__ void p0_prologue(const Args& a, LAS unsigned char* lds, int vcu, int G, int tid, int lane, int wave) {
    unsigned char* ws = a.ws;
    const float* x = a.in[0]; const float* n1g = a.in[1]; const float* w_in = a.in[2]; const float* w_sp = a.in[5]; const float* b_f = a.in[7];
    const float* wpa = a.in[9]; const float* wpb = a.in[10]; const float* wout = a.in[11];
    bf16* W1t = (bf16*)(ws + WS_W1); bf16* WGt = (bf16*)(ws + WS_WG); bf16* WABt = (bf16*)(ws + WS_WAB); bf16* WOt = (bf16*)(ws + WS_WO);
    bf16* WSM = (bf16*)(ws + WS_WSM); float* ssq = (float*)(ws + WS_SSQ); float* logf_ = (float*)(ws + WS_LOGF);
    bf16* XN = (bf16*)a.out;
    const int gw = vcu * NWAVES + wave, NGW = G * NWAVES, gt = vcu * 512 + tid, NGT = G * 512;
    LAS float* wf = (LAS float*)(lds + 73728);
    for (int k = tid; k < 1024; k += 512) { const f32x4 w0 = *(const f32x4*)(w_in + (size_t)k * NIN + 7168), w1 = *(const f32x4*)(w_in + (size_t)k * NIN + 7172);
        wf[0 * 1024 + k] = w0.x; wf[1 * 1024 + k] = w0.y; wf[2 * 1024 + k] = w0.z; wf[3 * 1024 + k] = w0.w; wf[4 * 1024 + k] = w1.x; wf[5 * 1024 + k] = w1.y; wf[6 * 1024 + k] = w1.z; wf[7 * 1024 + k] = w1.w; }
    LAS float* scr = (LAS float*)(lds + wave * 8448);
    constexpr int I1 = 16 * (NP1 / 32), IG = 16 * (NG / 32), IS = 16 * 32;
    for (int it = gw; it < I1; it += NGW) transpose_item(w_in, NIN, NP1 / 32, W1t, 1024, scr, it, lane);
    (void)IG; (void)IS; (void)WGt; (void)WABt; (void)WOt; (void)wpa; (void)wpb; (void)wout;
    for (int i = gt; i < 8 * 128 * 128; i += NGT) { const int s = i & 127, t = (i >> 7) & 127; const float v = ((t >> 6) >= (s >> 6)) ? w_sp[i] : 0.f; WSM[i] = (bf16)f2bf(v); }
    for (int i = gt; i < T; i += NGT) ssq[i] = 0.f;
    __syncthreads();
    const GAS f32x4* gp = (const GAS f32x4*)n1g + lane;
    f32x4 gv[4];
#pragma unroll
    for (int j = 0; j < 4; ++j) gv[j] = gp[64 * j];
    f32x4 nv[4];
    if (gw < T) { const GAS f32x4* xr0 = (const GAS f32x4*)(x + (size_t)gw * DM) + lane;
#pragma unroll
        for (int j = 0; j < 4; ++j) nv[j] = xr0[64 * j]; }
    for (int m = gw; m < T; m += NGW) {
        f32x4 v[4]; float s2 = 0.f;
#pragma unroll
        for (int j = 0; j < 4; ++j) { v[j] = nv[j]; s2 += (v[j].x * v[j].x + v[j].y * v[j].y) + (v[j].z * v[j].z + v[j].w * v[j].w); }
        if (m + NGW < T) { const GAS f32x4* xr = (const GAS f32x4*)(x + (size_t)(m + NGW) * DM) + lane;
#pragma unroll
            for (int j = 0; j < 4; ++j) nv[j] = xr[64 * j]; }
        const float rstd = 1.0f / sqrtf(wave_sum(s2) * (1.f / DM) + EPS);
#pragma unroll
        for (int j = 0; j < 4; ++j) v[j] = v[j] * rstd * gv[j];
        GAS unsigned long long* o8 = (GAS unsigned long long*)(XN + (size_t)m * DM) + lane;
#pragma unroll
        for (int j = 0; j < 4; ++j) o8[64 * j] = (unsigned long long)pk2(v[j].x, v[j].y) | ((unsigned long long)pk2(v[j].z, v[j].w) << 32);
        float f[8];
#pragma unroll
        for (int h = 0; h < 8; ++h) { float acc = 0.f;
#pragma unroll
            for (int j = 0; j < 4; ++j) { const f32x4 w = *(const LAS f32x4*)(wf + h * 1024 + 256 * j + 4 * lane); acc += (v[j].x * w.x + v[j].y * w.y) + (v[j].z * w.z + v[j].w * w.w); }
            f[h] = wave_sum(acc); }
        float fz = f[0];
#pragma unroll
        for (int h = 1; h < 8; ++h) fz = (lane == h) ? f[h] : fz;
        if (lane < 8) { const float z = fz + b_f[lane]; const float ls = fminf(z, 0.f) - log1pf(expf(-fabsf(z)));
            const int b = m >> 12, s = m & 4095; logf_[((size_t)(b * NH + lane) << 12) + s] = ls; }
    }
}
__device__ __forceinline__ void cumsum_bh(const float* logf_, float* cc, int bh, LAS unsigned char* lds, int tid, int lane, int wave) {
    LAS float* wt = (LAS float*)lds;
    const float* src = logf_ + (size_t)bh * SEQ + tid * 8; float* dst = cc + (size_t)bh * SEQ + tid * 8;
    f32x4 a = *(const f32x4*)src, b = *(const f32x4*)(src + 4);
    a.y += a.x; a.z += a.y; a.w += a.z; b.x += a.w; b.y += b.x; b.z += b.y; b.w += b.z;
    float tot = b.w, inc = tot;
#pragma unroll
    for (int o = 1; o < 64; o <<= 1) { const float n = __shfl_up(inc, o); if (lane >= o) inc += n; }
    if (lane == 63) wt[wave] = inc;
    __syncthreads();
    float base = inc - tot;
    for (int w = 0; w < wave; ++w) base += wt[w];
    a = a + base; b = b + base;
    *(f32x4*)dst = a; *(f32x4*)(dst + 4) = b;
    __syncthreads();
}
constexpr int VN_PITCH = 260, YT_PITCH = 528, YT_OFF = 128 * VN_PITCH;
__device__ __forceinline__ void sgu_item(LAS unsigned char* lds, const bf16* VA, bf16* AO, const bf16* ZA, const bf16* WSM, const float* ln_g, const float* ln_b, const float* b_sp,
                                         int rb, int g, int tid, int lane, int wave, v4u (&vin)[4], int rbn, int gn, bool has_next) {
    const int r0 = rb * 128;
    v4u ureg[4], zreg[4];
    {
        const int row = tid >> 2, q = tid & 3;
        const v4u* up0 = (const v4u*)(AO + (size_t)(r0 + row) * 2048 + g * 128 + q * 32);
        const v4u* zp0 = (const v4u*)(ZA + (size_t)(r0 + row) * 1024 + g * 128 + q * 32);
#pragma unroll
        for (int i = 0; i < 4; ++i) { ureg[i] = up0[i]; zreg[i] = zp0[i]; }
    }
    {
        const int row = tid >> 2, q = tid & 3;
        float v[32];
#pragma unroll
        for (int i = 0; i < 4; ++i) { const v4u w = vin[i];
            v[8 * i + 0] = __uint_as_float(w.x << 16); v[8 * i + 1] = __uint_as_float(w.x & 0xffff0000u); v[8 * i + 2] = __uint_as_float(w.y << 16); v[8 * i + 3] = __uint_as_float(w.y & 0xffff0000u);
            v[8 * i + 4] = __uint_as_float(w.z << 16); v[8 * i + 5] = __uint_as_float(w.z & 0xffff0000u); v[8 * i + 6] = __uint_as_float(w.w << 16); v[8 * i + 7] = __uint_as_float(w.w & 0xffff0000u); }
        float s = 0.f;
#pragma unroll
        for (int i = 0; i < 32; ++i) s += v[i];
        s += __shfl_xor(s, 1); s += __shfl_xor(s, 2);
        const float mu = s * (1.f / 128.f); float s2 = 0.f;
#pragma unroll
        for (int i = 0; i < 32; ++i) { v[i] -= mu; s2 += v[i] * v[i]; }
        s2 += __shfl_xor(s2, 1); s2 += __shfl_xor(s2, 2);
        const float rstd = 1.0f / sqrtf(s2 * (1.f / 128.f) + EPS);
        const f32x4* gp = (const f32x4*)(ln_g + g * 128 + q * 32); const f32x4* bp = (const f32x4*)(ln_b + g * 128 + q * 32);
        LAS unsigned* dst = (LAS unsigned*)(lds + row * VN_PITCH + q * 64);
#pragma unroll
        for (int i = 0; i < 8; ++i) { const f32x4 gg = gp[i], bb = bp[i];
            dst[2 * i] = pk2(v[4 * i] * rstd * gg.x + bb.x, v[4 * i + 1] * rstd * gg.y + bb.y);
            dst[2 * i + 1] = pk2(v[4 * i + 2] * rstd * gg.z + bb.z, v[4 * i + 3] * rstd * gg.w + bb.w); }
    }
    __syncthreads();
    if (has_next) {
        const int row = tid >> 2, q = tid & 3;
        const v4u* vp = (const v4u*)(VA + (size_t)(rbn * 128 + row) * 1024 + gn * 128 + q * 32);
#pragma unroll
        for (int i = 0; i < 4; ++i) vin[i] = vp[i];
    }
    {
        const int fr = lane & 15, fq = lane >> 4, c = 16 * wave + fr;
        bf16x8 X[4];
#pragma unroll
        for (int kb = 0; kb < 4; ++kb) {
            const LAS unsigned short* p = (const LAS unsigned short*)(lds + (32 * kb + 8 * fq) * VN_PITCH + c * 2);
#pragma unroll
            for (int j = 0; j < 8; ++j) X[kb][j] = (short)p[j * (VN_PITCH / 2)];
        }
        const bf16* wg = WSM + (size_t)g * 16384 + fr * 128 + 8 * fq;
        f32x4 acc[8];
#pragma unroll
        for (int m = 0; m < 8; ++m) { acc[m] = (f32x4){0.f, 0.f, 0.f, 0.f};
#pragma unroll
            for (int kb = 0; kb < 4; ++kb) { if (m < 4 && kb >= 2) continue;
                const bf16x8 Y = *(const bf16x8*)(wg + m * 2048 + kb * 32);
                acc[m] = __builtin_amdgcn_mfma_f32_16x16x32_bf16(X[kb], Y, acc[m], 0, 0, 0); } }
#pragma unroll
        for (int m = 0; m < 8; ++m) { const int t = 16 * m + fr; const float bs = b_sp[g * 128 + t];
            *(LAS f32x4*)(lds + YT_OFF + t * YT_PITCH + (16 * wave + 4 * fq) * 4) = acc[m] + bs; }
    }
    __syncthreads();
    {
        const int row = tid >> 2, q = tid & 3;
        v4u* up = (v4u*)(AO + (size_t)(r0 + row) * 2048 + g * 128 + q * 32);
        const LAS f32x4* yp = (const LAS f32x4*)(lds + YT_OFF + row * YT_PITCH + q * 128);
#pragma unroll
        for (int i = 0; i < 4; ++i) { const v4u u = ureg[i], z = zreg[i]; const f32x4 y0 = yp[2 * i], y1 = yp[2 * i + 1];
            v4u o;
            o.x = pk2(__uint_as_float(u.x << 16) * y0.x * __uint_as_float(z.x << 16), __uint_as_float(u.x & 0xffff0000u) * y0.y * __uint_as_float(z.x & 0xffff0000u));
            o.y = pk2(__uint_as_float(u.y << 16) * y0.z * __uint_as_float(z.y << 16), __uint_as_float(u.y & 0xffff0000u) * y0.w * __uint_as_float(z.y & 0xffff0000u));
            o.z = pk2(__uint_as_float(u.z << 16) * y1.x * __uint_as_float(z.z << 16), __uint_as_float(u.z & 0xffff0000u) * y1.y * __uint_as_float(z.z & 0xffff0000u));
            o.w = pk2(__uint_as_float(u.w << 16) * y1.z * __uint_as_float(z.w << 16), __uint_as_float(u.w & 0xffff0000u) * y1.w * __uint_as_float(z.w & 0xffff0000u));
            up[i] = o; }
    }
}


__device__ __forceinline__ void late_transposes(const Args& a, LAS unsigned char* lds, int vcu, int G, int lane, int wave) {
    unsigned char* ws = a.ws; const float* w_in = a.in[2]; const float* wpa = a.in[9]; const float* wpb = a.in[10]; const float* wout = a.in[11];
    bf16* WGt = (bf16*)(ws + WS_WG); bf16* WABt = (bf16*)(ws + WS_WAB); bf16* WOt = (bf16*)(ws + WS_WO);
    LAS float* scr = (LAS float*)(lds + wave * 8448);
    constexpr int IG = 16 * (NG / 32), IS = 16 * 32;
    const int gw = vcu * NWAVES + wave, NGW = G * NWAVES;
    for (int it = gw; it < IG + 3 * IS; it += NGW) {
        int r = it;
        if (r < IG) { transpose_item(w_in + 7176, NIN, NG / 32, WGt, 1024, scr, r, lane); continue; } r -= IG;
        if (r < IS) { transpose_item(wpa, 1024, 32, WABt, 2048, scr, r, lane); continue; } r -= IS;
        if (r < IS) { transpose_item(wpb, 1024, 32, WABt + 1024, 2048, scr, r, lane); continue; } r -= IS;
        transpose_item(wout, 1024, 32, WOt, 1024, scr, r, lane);
    }
}

__global__ void __launch_bounds__(NWAVES * 64, 2) fwd_mega(Args args) {
    extern __shared__ __attribute__((aligned(16))) unsigned char lds_raw[];
    LAS unsigned char* lds = (LAS unsigned char*)lds_raw;
    __builtin_assume(__builtin_amdgcn_workitem_id_y() == 0); __builtin_assume(__builtin_amdgcn_workitem_id_z() == 0);
    const int wave = __builtin_amdgcn_readfirstlane(threadIdx.x >> 6);
#define PH_IDS() int tid = threadIdx.x; asm volatile("" : "+v"(tid)); const int lane = tid & 63
    const int G = gridDim.x; const int bx = blockIdx.x; const int vcu = (G % 8 == 0) ? (bx % 8) * (G / 8) + bx / 8 : bx;
    unsigned char* ws = args.ws;
    const int lo = args.ph_lo, hi = args.ph_hi;
#define IN(k) (lo <= (k) && (k) < hi)
#define SEAM(k) do { if (IN(k) && IN((k) + 1)) { if ((k) == 0) cg::this_grid().sync(); else xcd_barrier(xbar); } } while (0)
    { volatile LAS unsigned* m_ = (volatile LAS unsigned*)(lds + MISC_OFF); if (threadIdx.x < 16) m_[threadIdx.x] = 0u; }
    __syncthreads();
    if (lo == 0) { unsigned* bz = (unsigned*)(ws + WS_BAR); for (int i = blockIdx.x * (NWAVES * 64) + threadIdx.x; i < BAR_BYTES / 4; i += gridDim.x * (NWAVES * 64)) bz[i] = 0u; }
    XcdBarrier xbar; xbar.bar = (unsigned*)(ws + WS_BAR); xbar.x = 0; xbar.st = (volatile LAS unsigned*)(lds + MISC_OFF);
    bf16* XN = (bf16*)args.out;
    bf16* AO = (bf16*)(ws + WS_AO); bf16* VA = (bf16*)(ws + WS_VA); bf16* ZA = (bf16*)(ws + WS_ZA); bf16* KB = (bf16*)(ws + WS_K); bf16* VB = (bf16*)(ws + WS_V); bf16* ZB = (bf16*)(ws + WS_ZB);
    bf16* GA = VA; bf16* GB = ZA; bf16* MG = KB;
    float* ssq = (float*)(ws + WS_SSQ); float* logf_ = (float*)(ws + WS_LOGF); float* cc = (float*)(ws + WS_CC);

    if (IN(0)) { PH_IDS(); p0_prologue(args, lds, vcu, G, tid, lane, wave); __syncthreads(); }
    SEAM(0);
    xbar = xcd_barrier_post((unsigned*)(ws + WS_BAR), (volatile LAS unsigned*)(lds + MISC_OFF));
    if (IN(1)) {
        { PH_IDS(); for (int bh = vcu; bh < BATCH * NH; bh += G) cumsum_bh(logf_, cc, bh, lds, tid, lane, wave); }
        pg8::Gemm g{XN, (const bf16*)(ws + WS_W1), T, NP1, DM}; pg8::StaticOrder S; S.init(T, NP1, G, bx);
        pg8::EpiP1 E{AO, VA, ZA, KB, VB, ZB};
        pg8::gemm_phase<pg8::EpiP1, pg8::StaticOrder, true, true>(lds, g, S, E);
    }
    SEAM(1);
    if (IN(2)) {
        const bf16* WSM = (const bf16*)(ws + WS_WSM);
        const fa::Tensors FT{AO, KB, VB, ZB, cc};
        if (vcu & 1) { fa::fox_phase((char*)lds_raw, FT, vcu, G); __syncthreads(); { PH_IDS(); v4u vin[4];
                if (vcu < 2048) { const v4u* vp = (const v4u*)(VA + (size_t)((vcu >> 3) * 128 + (tid >> 2)) * 1024 + (vcu & 7) * 128 + (tid & 3) * 32);
#pragma unroll
                    for (int i = 0; i < 4; ++i) vin[i] = vp[i]; }
                for (int it = vcu; it < 2048; it += G) { const int itn = it + G; sgu_item(lds, VA, AO, ZA, WSM, args.in[3], args.in[4], args.in[6], it >> 3, it & 7, tid, lane, wave, vin, itn >> 3, itn & 7, itn < 2048); } __syncthreads(); late_transposes(args, lds, vcu, G, lane, wave); } }
        else { { PH_IDS(); v4u vin[4];
                if (vcu < 2048) { const v4u* vp = (const v4u*)(VA + (size_t)((vcu >> 3) * 128 + (tid >> 2)) * 1024 + (vcu & 7) * 128 + (tid & 3) * 32);
#pragma unroll
                    for (int i = 0; i < 4; ++i) vin[i] = vp[i]; }
                for (int it = vcu; it < 2048; it += G) { const int itn = it + G; sgu_item(lds, VA, AO, ZA, WSM, args.in[3], args.in[4], args.in[6], it >> 3, it & 7, tid, lane, wave, vin, itn >> 3, itn & 7, itn < 2048); } __syncthreads(); late_transposes(args, lds, vcu, G, lane, wave); } __syncthreads(); fa::fox_phase((char*)lds_raw, FT, vcu, G); }
    }
    SEAM(2);
    if (IN(3)) {
        pg8::Gemm g{XN, (const bf16*)(ws + WS_WG), T, NG, DM}; pg8::StaticOrder S; S.init(T, NG, G, bx);
        pg8::EpiGate E{GA, GB, args.in[8]};
        pg8::gemm_phase<pg8::EpiGate, pg8::StaticOrder, true, true>(lds, g, S, E);
    }
    if (G != 256) SEAM(3);
    if (IN(4)) {
        pg8::Gemm g{AO, (const bf16*)(ws + WS_WAB), T, DM, 2 * DM}; pg8::StaticOrder S; S.init(T, DM, G, bx);
        pg8::EpiMerged E{GA, GB, MG};
        pg8::gemm_phase<pg8::EpiMerged, pg8::StaticOrder, true, true>(lds, g, S, E);
    }
    SEAM(4);
    if (IN(5)) {
        pg8::Gemm g{MG, (const bf16*)(ws + WS_WO), T, DM, DM}; pg8::StaticOrder S; S.init(T, DM, G, bx);
        if (N_LAUNCHES == 1) { pg8::EpiOutNorm E{args.in[0], args.out, ssq, (unsigned*)(ws + WS_CNT), args.in[12], EPS};
            pg8::gemm_phase<pg8::EpiOutNorm, pg8::StaticOrder, true, true>(lds, g, S, E); }
        else { pg8::EpiOut E{args.in[0], args.out, ssq};
            pg8::gemm_phase<pg8::EpiOut, pg8::StaticOrder, true, true>(lds, g, S, E); }
    }
    if (N_LAUNCHES != 1) SEAM(5);
    if (IN(6) && N_LAUNCHES != 1) {
        PH_IDS(); const float* nfg = args.in[12];
        const int gw = vcu * NWAVES + wave, NGW = G * NWAVES;
        const GAS f32x4* gp = (const GAS f32x4*)nfg + lane;
        f32x4 gv[4];
#pragma unroll
        for (int j = 0; j < 4; ++j) gv[j] = gp[64 * j];
        for (int m = gw; m < T; m += NGW) {
            GAS f32x4* hr = (GAS f32x4*)(args.out + (size_t)m * DM) + lane;
            const float rstd = 1.0f / sqrtf(ssq[m] * (1.f / DM) + EPS);
#pragma unroll
            for (int j = 0; j < 4; ++j) { const f32x4 h = hr[64 * j]; hr[64 * j] = h * rstd * gv[j]; }
        }
    }
#undef IN
#undef SEAM
}


extern "C" void kernel_launch(void* const* d_in, const int* in_sizes, int n_in, void* d_out, int out_size, void* d_ws, size_t ws_size, hipStream_t stream) {
    static int grid = 0;
    if (grid == 0) {
        if (n_in != 13 || in_sizes[0] != T * DM || out_size != T * DM || ws_size < WS_END) { fprintf(stderr, "kernel_launch: shape/workspace mismatch (n_in %d, in0 %d, out %d, ws %zu)\n", n_in, n_in > 0 ? in_sizes[0] : -1, out_size, ws_size); grid = -1; return; }
        int dev = 0, cus = 0, per_cu = 0;
        if (hipGetDevice(&dev) != hipSuccess || hipDeviceGetAttribute(&cus, hipDeviceAttributeMultiprocessorCount, dev) != hipSuccess) { grid = -1; return; }
        if (hipFuncSetAttribute((const void*)fwd_mega, hipFuncAttributeMaxDynamicSharedMemorySize, LDS_BYTES) != hipSuccess) { fprintf(stderr, "kernel_launch: hipFuncSetAttribute failed\n"); grid = -1; return; }
        if (hipOccupancyMaxActiveBlocksPerMultiprocessor(&per_cu, (const void*)fwd_mega, NWAVES * 64, LDS_BYTES) != hipSuccess || per_cu < 1) { fprintf(stderr, "kernel_launch: occupancy query says %d\n", per_cu); per_cu = 1; }
        (void)hipGetLastError();
        grid = cus;
    }
    if (grid < 0) return;
    Args a{};
    for (int i = 0; i < 13; ++i) a.in[i] = (const float*)d_in[i];
    a.out = (float*)d_out; a.ws = (unsigned char*)d_ws;
    if (N_LAUNCHES == 1) {
        a.ph_lo = 0; a.ph_hi = N_PHASES;
        void* kargs[] = {&a};
        hipError_t e = hipLaunchCooperativeKernel((const void*)fwd_mega, dim3(grid), dim3(NWAVES * 64), kargs, LDS_BYTES, stream);
        if (e != hipSuccess) fprintf(stderr, "kernel_launch: cooperative launch failed: %s (grid %d)\n", hipGetErrorString(e), grid);
    } else {
        for (int p = 0; p < N_PHASES; ++p) { a.ph_lo = p; a.ph_hi = p + 1; hipLaunchKernelGGL(fwd_mega, dim3(grid), dim3(NWAVES * 64), LDS_BYTES, stream, a); }
    }
}
```
